# Optimizing an MI355X kernel written in HIP

```python
import math
import jax, jax.numpy as jnp
from jax import lax
import numpy as np

D_MODEL = 1024
BATCH = 4
SEQ = 4096
DEPTH = 2

EXPAND = 2
D_INNER = EXPAND * D_MODEL
IN_COLS = 3 * D_INNER
POOL_WIDTH = D_INNER // 2
POOL_GROUPS = 4
POOL_GROUP_DIM = POOL_WIDTH // POOL_GROUPS
POOL_WINDOWS = (2, 4, 8, 16)
ATTN_WIDTH = D_INNER - POOL_WIDTH
N_DIFF_HEADS = 8
DIFF_VDIM = ATTN_WIDTH // N_DIFF_HEADS
DIFF_QKDIM = DIFF_VDIM // 2
ROPE_THETA = 500000.0
ROPE_DIM = DIFF_QKDIM // 4
Q_BLOCK = 128
SGU_CHUNK = 128
SGU_GROUPS = 8
SGU_GROUP_DIM = D_INNER // SGU_GROUPS
EPS = 1e-6
N_AB = (DEPTH + 1) // 2
N_C = DEPTH // 2

kernel_name = "hybrid_pool_diffattn_sgu_trunk"


def rms_norm(x, g, eps=EPS):
    xf = x.astype(jnp.float32)
    y = xf * lax.rsqrt(jnp.mean(xf * xf, axis=-1, keepdims=True) + eps)
    return (y * g.astype(jnp.float32)).astype(x.dtype)


def multiscale_pool(a, pool_w, pool_scale):
    B, S, _ = a.shape
    ag = a.reshape(B, S, POOL_GROUPS, POOL_GROUP_DIM).astype(jnp.float32)
    csum = lax.cumsum(ag, axis=1)
    pos = jnp.arange(S)
    means = []
    for g, w in enumerate(POOL_WINDOWS):
        c = csum[:, :, g]
        lagged = jnp.pad(c, ((0, 0), (w, 0), (0, 0)))[:, :S]
        cnt = jnp.minimum(pos + 1, w).astype(jnp.float32)[None, :, None]
        means.append((c - lagged) / cnt)
    pooled = (jnp.stack(means, axis=2) - ag).astype(a.dtype)
    y = jnp.einsum('bsgc,gcd->bsgd', pooled, pool_w)
    y = y * pool_scale.reshape(POOL_GROUPS, POOL_GROUP_DIM)
    return y.reshape(B, S, POOL_WIDTH)


def apply_partial_rope(t, positions):
    half = ROPE_DIM // 2
    inv_freq = jnp.power(ROPE_THETA, -jnp.arange(half, dtype=jnp.float32) * 2.0 / ROPE_DIM)
    ang = positions.astype(jnp.float32)[:, :, None] * inv_freq
    cos = jnp.cos(ang)[:, :, None, None, :]
    sin = jnp.sin(ang)[:, :, None, None, :]
    tf = t.astype(jnp.float32)
    x1 = tf[..., :half]
    x2 = tf[..., half:ROPE_DIM]
    rot = jnp.concatenate([x1 * cos - x2 * sin, x2 * cos + x1 * sin, tf[..., ROPE_DIM:]], axis=-1)
    return rot.astype(t.dtype)


def diff_attention(q, k, v, lam, positions):
    B, S = q.shape[:2]
    q = apply_partial_rope(q, positions)
    k = apply_partial_rope(k, positions)
    nb = S // Q_BLOCK
    qb = q.reshape(B, nb, Q_BLOCK, N_DIFF_HEADS, 2, DIFF_QKDIM).swapaxes(0, 1)
    kpos = jnp.arange(S)
    scale = DIFF_QKDIM ** -0.5

    def one_block(args):
        q_blk, blk = args
        s = jnp.einsum('bqhcd,bkhcd->bhcqk', q_blk, k).astype(jnp.float32) * scale
        qpos = blk * Q_BLOCK + jnp.arange(Q_BLOCK)
        s = jnp.where(kpos[None, :] <= qpos[:, None], s, -jnp.inf)
        p = jax.nn.softmax(s, axis=-1)
        w = (p[:, :, 0] - lam * p[:, :, 1]).astype(v.dtype)
        return jnp.einsum('bhqk,bkhd->bqhd', w, v)

    o = lax.map(one_block, (qb, jnp.arange(nb)))
    return o.swapaxes(0, 1).reshape(B, S, N_DIFF_HEADS, DIFF_VDIM)


def chunked_sgu(u, v, ln_g, ln_b, w_s, b_s):
    B, S, _ = u.shape
    vf = v.astype(jnp.float32)
    mu = jnp.mean(vf, axis=-1, keepdims=True)
    var = jnp.mean(jnp.square(vf - mu), axis=-1, keepdims=True)
    vn = ((vf - mu) * lax.rsqrt(var + EPS) * ln_g + ln_b).astype(v.dtype)
    nc = S // SGU_CHUNK
    vc = vn.reshape(B, nc, SGU_CHUNK, SGU_GROUPS, SGU_GROUP_DIM)
    mask = jnp.tril(jnp.ones((SGU_CHUNK, SGU_CHUNK), dtype=bool))
    ws = jnp.where(mask[None], w_s, jnp.zeros_like(w_s))
    mixed = jnp.einsum('gts,bcsgd->bctgd', ws, vc) + b_s.T[None, None, :, :, None]
    return u * mixed.reshape(B, S, D_INNER)


def setup_inputs(seed: int = 0) -> dict:
    key = jax.random.key(seed)
    ks = jax.random.split(key, 20)
    f32 = jnp.float32
    nrm = lambda k, shape, s: (jax.random.normal(k, shape, f32) * s).astype(f32)
    x = jax.random.normal(ks[0], (BATCH, SEQ, D_MODEL), f32)
    positions = jnp.broadcast_to(jnp.arange(SEQ, dtype=jnp.int32), (BATCH, SEQ))
    pre_norm = 1.0 + nrm(ks[1], (DEPTH, D_MODEL), 0.02)
    post_norm = 1.0 + nrm(ks[2], (DEPTH, D_MODEL), 0.02)
    w_in = nrm(ks[3], (DEPTH, D_MODEL, IN_COLS), D_MODEL ** -0.5)
    w_out = nrm(ks[4], (DEPTH, D_INNER, D_MODEL), D_INNER ** -0.5)
    pool_w = nrm(ks[5], (N_AB, POOL_GROUPS, POOL_GROUP_DIM, POOL_GROUP_DIM), POOL_GROUP_DIM ** -0.5)
    pool_scale = 1.0 + nrm(ks[6], (N_AB, POOL_WIDTH), 0.02)
    lam_q1 = nrm(ks[7], (N_AB, DIFF_QKDIM), 0.1)
    lam_k1 = nrm(ks[8], (N_AB, DIFF_QKDIM), 0.1)
    lam_q2 = nrm(ks[9], (N_AB, DIFF_QKDIM), 0.1)
    lam_k2 = nrm(ks[10], (N_AB, DIFF_QKDIM), 0.1)
    diff_subln = 1.0 + nrm(ks[11], (N_AB, DIFF_VDIM), 0.02)
    sgu_ln_g = 1.0 + nrm(ks[12], (N_C, D_INNER), 0.02)
    sgu_ln_b = nrm(ks[13], (N_C, D_INNER), 0.02)
    sgu_w = nrm(ks[14], (N_C, SGU_GROUPS, SGU_CHUNK, SGU_CHUNK), SGU_CHUNK ** -0.5)
    sgu_b = 1.0 + nrm(ks[15], (N_C, SGU_GROUPS, SGU_CHUNK), 0.02)
    return {"x": x, "positions": positions, "pre_norm": pre_norm, "post_norm": post_norm,
            "w_in": w_in, "w_out": w_out, "pool_w": pool_w, "pool_scale": pool_scale,
            "lam_q1": lam_q1, "lam_k1": lam_k1, "lam_q2": lam_q2, "lam_k2": lam_k2,
            "diff_subln": diff_subln, "sgu_ln_g": sgu_ln_g, "sgu_ln_b": sgu_ln_b,
            "sgu_w": sgu_w, "sgu_b": sgu_b}


def reference(x, positions, pre_norm, post_norm, w_in, w_out, pool_w, pool_scale,
              lam_q1, lam_k1, lam_q2, lam_k2, diff_subln, sgu_ln_g, sgu_ln_b, sgu_w, sgu_b):
    B, S, _ = x.shape
    for layer in range(DEPTH):
        h = rms_norm(x, pre_norm[layer])
        proj = jnp.einsum('bsd,de->bse', h, w_in[layer])
        if layer % 2 == 0:
            i = layer // 2
            a = proj[..., :POOL_WIDTH]
            q = proj[..., POOL_WIDTH:2 * POOL_WIDTH].reshape(B, S, N_DIFF_HEADS, 2, DIFF_QKDIM)
            k = proj[..., 2 * POOL_WIDTH:3 * POOL_WIDTH].reshape(B, S, N_DIFF_HEADS, 2, DIFF_QKDIM)
            v = proj[..., 3 * POOL_WIDTH:D_INNER + ATTN_WIDTH * 2].reshape(B, S, N_DIFF_HEADS, DIFF_VDIM)
            gate = proj[..., 2 * D_INNER:]
            pool_out = multiscale_pool(a, pool_w[i], pool_scale[i])
            lam_init = 0.8 - 0.6 * math.exp(-0.3 * layer)
            lam = (jnp.exp(jnp.sum(lam_q1[i].astype(jnp.float32) * lam_k1[i].astype(jnp.float32)))
                   - jnp.exp(jnp.sum(lam_q2[i].astype(jnp.float32) * lam_k2[i].astype(jnp.float32)))
                   + lam_init)
            o = diff_attention(q, k, v, lam, positions)
            o = rms_norm(o, diff_subln[i], eps=1e-5) * (1.0 - lam_init)
            y = jnp.concatenate([pool_out, o.reshape(B, S, ATTN_WIDTH)], axis=-1)
        else:
            i = layer // 2
            u = jax.nn.gelu(proj[..., :D_INNER])
            v = jax.nn.gelu(proj[..., D_INNER:2 * D_INNER])
            gate = proj[..., 2 * D_INNER:]
            y = chunked_sgu(u, v, sgu_ln_g[i], sgu_ln_b[i], sgu_w[i], sgu_b[i])
        out = jnp.einsum('bse,ed->bsd', jax.nn.silu(gate) * y, w_out[layer])
        x = x + rms_norm(out, post_norm[layer])
    return x
```

```cpp
#include <hip/hip_runtime.h>
#include <hip/hip_cooperative_groups.h>
#include <cstdio>
#include <cstdint>

namespace pg8 {
#define PG8_LAS __attribute__((address_space(3)))
typedef unsigned short bf16_t;
typedef short bf16x8 __attribute__((ext_vector_type(8)));
typedef float f32x4 __attribute__((ext_vector_type(4)));
typedef unsigned u32x4 __attribute__((ext_vector_type(4)));
constexpr int BM = 256, BK = 64, HALF = 128, HTB = HALF * BK * 2  , STAGE_BYTES = 8 * HTB, NXCD = 8, WGM = 8;

__host__ __device__ __forceinline__ int lds_byte(int r, int c) { const int st = (r >> 4) * 2 + (c >> 5), rr = r & 15, cc = c & 31, ob = rr * 64 + cc * 2; return st * 1024 + (ob ^ (((ob >> 9) & 1) << 5)); }
__host__ __device__ __forceinline__ void stage_rc(int b, int& R, int& C) { const int st = b / 1024, sb = b % 1024, swz = sb ^ (((sb >> 9) & 1) << 5); R = (st >> 1) * 16 + swz / 64; C = (st & 1) * 32 + (swz % 64) / 2; }
__host__ __device__ __forceinline__ int perm32(int rho) { const int n = rho >> 4, i = rho & 15; return 8 * (i >> 2) + 4 * n + (i & 3); }

struct Unit { int pm, pn; };
struct Gemm { const bf16_t* A; const bf16_t* Bt; int M, N, K, lda, ldb, a_pn_bytes; };

struct StaticOrder {
    int nM, nN, nwg, G, c;
    __host__ __device__ void init(int M, int N, int G_, int c_) { nM = M / BM; nN = N / BM; nwg = nM * nN; G = G_; c = c_; }
    __host__ __device__ bool next(int i, Unit& u) const {
        const long L = (long)i * G + c; if (L >= nwg) return false;
        int wgid = (int)L; { const int q = nwg / NXCD, r = nwg % NXCD, xcd = wgid % NXCD, off = wgid / NXCD; wgid = (xcd < r ? xcd * (q + 1) : r * (q + 1) + (xcd - r) * q) + off; }
        const int nig = WGM * nN, gid = wgid / nig, fm = gid * WGM, gsz = (nM - fm) < WGM ? (nM - fm) : WGM;
        u.pm = fm + ((wgid % nig) % gsz); u.pn = (wgid % nig) / gsz; return true;
    }
    __device__ __forceinline__ void a_ready(const Unit&) const {}
    __device__ __forceinline__ void done(const Unit&) const {}
};

typedef float f32x2c_t __attribute__((ext_vector_type(2))); typedef __bf16 bf16x2c_t __attribute__((ext_vector_type(2)));
__device__ __forceinline__ unsigned cvt_pk_bf16(float lo, float hi) { const f32x2c_t v = {lo, hi}; const bf16x2c_t b = __builtin_convertvector(v, bf16x2c_t); return __builtin_bit_cast(unsigned, b); }
__device__ __forceinline__ float silu_f(float x) { return x * __builtin_amdgcn_rcpf(1.0f + __builtin_amdgcn_exp2f(-1.4426950408889634f * x)); }
__device__ __forceinline__ float gelu_tanh_f(float x) { const float z = 0.7978845608028654f * (x + 0.044715f * x * x * x); return x * __builtin_amdgcn_rcpf(1.0f + __builtin_amdgcn_exp2f(-2.8853900817779268f * z)); }
__device__ __forceinline__ u32x4 pack8(const f32x4& v0, const f32x4& v1) { u32x4 w; w.x = cvt_pk_bf16(v0[0], v0[1]); w.y = cvt_pk_bf16(v0[2], v0[3]); w.z = cvt_pk_bf16(v1[0], v1[1]); w.w = cvt_pk_bf16(v1[2], v1[3]); return w; }
template <int X> __device__ __forceinline__ float swz_xor(float v) { return __int_as_float(__builtin_amdgcn_ds_swizzle(__float_as_int(v), (X << 10) | 0x1F)); }
__device__ __forceinline__ float half_sum(float v) { auto rr = __builtin_amdgcn_permlane32_swap(__float_as_uint(v), __float_as_uint(v), false, false); return __uint_as_float(rr[0]) + __uint_as_float(rr[1]); }
__device__ __forceinline__ f32x4 shx16(const f32x4& v) { f32x4 r; r[0] = swz_xor<16>(v[0]); r[1] = swz_xor<16>(v[1]); r[2] = swz_xor<16>(v[2]); r[3] = swz_xor<16>(v[3]); return r; }

struct EpiProj0 {
    static constexpr bool PERM = true, AFTER_DRAIN = false;
    bf16_t *A, *G; size_t rstride; const float* rope; float qscale;
    __device__ __forceinline__ void operator()(const f32x4 (&acc)[2][2][4][2], const Unit& u, int wr, int wc, int fr, int fq) const {
        const int row0 = u.pm * BM + wr * 64 + fr, pn = u.pn, reg = pn >> 2;
        bf16_t* base; int ldc, colt;
        if (reg < 4) { base = A + (size_t)reg * rstride; ldc = 1024; colt = (pn & 3) * 256; } else { base = G; ldc = 2048; colt = (pn - 16) * 256; }
        const int col0 = colt + wc * 32 + 8 * fq;

#ifdef PROBE_ROPE
        const bool rot_tile = false,
#else
        const bool rot_tile = (reg == 1 || reg == 2),
#endif
        rot_lane = ((wc & 1) == 0) && (fq < 2), gate = reg >= 4;
        const float sc = (reg == 1) ? qscale : 1.f, sgn = (fq == 0) ? -1.f : 1.f;
#pragma unroll
        for (int ai = 0; ai < 2; ++ai)
#pragma unroll
            for (int m = 0; m < 4; ++m) { const int row = row0 + ai * HALF + m * 16; bf16_t* rowp = base + (size_t)row * ldc + col0;
                f32x4 c0 = {1.f, 1.f, 1.f, 1.f}, c1 = c0, s0 = {0.f, 0.f, 0.f, 0.f}, s1 = s0;
                if (rot_tile) { const f32x4* rp = (const f32x4*)(rope + (size_t)row * 16); c0 = rp[0]; c1 = rp[1]; s0 = rp[2]; s1 = rp[3]; }
#pragma unroll
                for (int bj = 0; bj < 2; ++bj) { f32x4 v0 = acc[ai][bj][m][0], v1 = acc[ai][bj][m][1];
                    if (rot_tile) { const f32x4 p0 = shx16(v0), p1 = shx16(v1); const f32x4 r0 = v0 * c0 + (p0 * s0) * sgn, r1 = v1 * c1 + (p1 * s1) * sgn; if (rot_lane) { v0 = r0; v1 = r1; } }
                    if (gate) {
#pragma unroll
                        for (int j = 0; j < 4; ++j) { v0[j] = silu_f(v0[j]); v1[j] = silu_f(v1[j]); } }
                    v0 = v0 * sc; v1 = v1 * sc;
                    *(u32x4*)(rowp + bj * HALF) = pack8(v0, v1); } }
    }
};
struct EpiProj1 {
    static constexpr bool PERM = true, AFTER_DRAIN = false;
    bf16_t *U; size_t rstride; float* stats;
    __device__ __forceinline__ void operator()(const f32x4 (&acc)[2][2][4][2], const Unit& u, int wr, int wc, int fr, int fq) const {
        const int row0 = u.pm * BM + wr * 64 + fr, pn = u.pn, reg = pn >> 3;
        bf16_t* base = U + (size_t)reg * rstride; const int col0 = (pn & 7) * 256 + wc * 32 + 8 * fq;
#pragma unroll
        for (int ai = 0; ai < 2; ++ai)
#pragma unroll
            for (int m = 0; m < 4; ++m) { const int row = row0 + ai * HALF + m * 16; bf16_t* rowp = base + (size_t)row * 2048 + col0; float s = 0.f, q = 0.f;
#pragma unroll
                for (int bj = 0; bj < 2; ++bj) { f32x4 v0 = acc[ai][bj][m][0], v1 = acc[ai][bj][m][1];
#pragma unroll
                    for (int j = 0; j < 4; ++j) { if (reg == 2) { v0[j] = silu_f(v0[j]); v1[j] = silu_f(v1[j]); } else { v0[j] = gelu_tanh_f(v0[j]); v1[j] = gelu_tanh_f(v1[j]); } }
                    if (reg == 1) {
#pragma unroll
                        for (int j = 0; j < 4; ++j) { s += v0[j] + v1[j]; q += v0[j] * v0[j] + v1[j] * v1[j]; } }
                    *(u32x4*)(rowp + bj * HALF) = pack8(v0, v1); }
                if (reg == 1) { s += swz_xor<16>(s); s = half_sum(s); q += swz_xor<16>(q); q = half_sum(q);
                    if (fq == 0) { float* sp = stats + ((size_t)row * 32 + (pn - 8) * 4 + wc) * 2; sp[0] = s; sp[1] = q; } } }
    }
};
struct EpiF32 {
    static constexpr bool PERM = true, AFTER_DRAIN = false;
    float* O; int ldc;
    __device__ __forceinline__ void operator()(const f32x4 (&acc)[2][2][4][2], const Unit& u, int wr, int wc, int fr, int fq) const {
        const int row0 = u.pm * BM + wr * 64 + fr, col0 = u.pn * BM + wc * 32 + 8 * fq;
#pragma unroll
        for (int ai = 0; ai < 2; ++ai)
#pragma unroll
            for (int m = 0; m < 4; ++m) { float* rowp = O + (size_t)(row0 + ai * HALF + m * 16) * ldc + col0;
#pragma unroll
                for (int bj = 0; bj < 2; ++bj) { *(f32x4*)(rowp + bj * HALF) = acc[ai][bj][m][0]; *(f32x4*)(rowp + bj * HALF + 4) = acc[ai][bj][m][1]; } }
    }
};
struct EpiPool {
    static constexpr bool PERM = true, AFTER_DRAIN = false;
    bf16_t* Y; const bf16_t* G; const float* scale;
    __device__ __forceinline__ void operator()(const f32x4 (&acc)[2][2][4][2], const Unit& u, int wr, int wc, int fr, int fq) const {
        const int row0 = u.pm * BM + wr * 64 + fr, col0 = u.pn * BM + wc * 32 + 8 * fq;
        f32x4 sv[2][2];
#pragma unroll
        for (int bj = 0; bj < 2; ++bj) { sv[bj][0] = *(const f32x4*)(scale + col0 + bj * HALF); sv[bj][1] = *(const f32x4*)(scale + col0 + bj * HALF + 4); }
#pragma unroll
        for (int ai = 0; ai < 2; ++ai)
#pragma unroll
            for (int m = 0; m < 4; ++m) { const size_t off = (size_t)(row0 + ai * HALF + m * 16) * 2048 + col0;
#pragma unroll
                for (int bj = 0; bj < 2; ++bj) { const u32x4 gw = *(const u32x4*)(G + off + bj * HALF);
                    f32x4 g0, g1; g0[0] = __uint_as_float(gw.x << 16); g0[1] = __uint_as_float(gw.x & 0xffff0000u); g0[2] = __uint_as_float(gw.y << 16); g0[3] = __uint_as_float(gw.y & 0xffff0000u);
                    g1[0] = __uint_as_float(gw.z << 16); g1[1] = __uint_as_float(gw.z & 0xffff0000u); g1[2] = __uint_as_float(gw.w << 16); g1[3] = __uint_as_float(gw.w & 0xffff0000u);
                    const f32x4 v0 = acc[ai][bj][m][0] * sv[bj][0] * g0, v1 = acc[ai][bj][m][1] * sv[bj][1] * g1;
                    *(u32x4*)(Y + off + bj * HALF) = pack8(v0, v1); } }
    }
};

template <class Epi, class Sched, bool ALIGN_EPI = false, bool SP2 = false>
__device__ __forceinline__ void gemm_phase(PG8_LAS unsigned char* lds, const Gemm g, const Sched& S, const Epi& E) {
    int tid_ = threadIdx.x; asm volatile("" : "+v"(tid_));
    const int tid = tid_, wid = __builtin_amdgcn_readfirstlane(tid >> 6), lane = tid & 63, wr = wid >> 2, wc = wid & 3, fr = lane & 15, fq = lane >> 4;
    const int K = g.K, nt = K / BK;
    unsigned voffA[2], voffB[2];
#pragma unroll
    for (int i = 0; i < 2; ++i) { int R, C; stage_rc(tid * 16 + i * 8192, R, C); const int Rb = Epi::PERM ? ((R & ~31) + perm32(R & 31)) : R;
        voffA[i] = (unsigned)(R * g.lda + C) * 2u; voffB[i] = (unsigned)(Rb * g.ldb + C) * 2u; }
    const size_t kstep = (size_t)(BK * 2);
    const size_t hstepA = (size_t)HALF * g.lda * 2, hstepB = (size_t)HALF * g.ldb * 2;
    const size_t tstepA = 2 * hstepA, tstepB = 2 * hstepB, apn = (size_t)g.a_pn_bytes;
    const unsigned ldsw = (unsigned)wid * 1024u;
    const int aoff = lds_byte(wr * 64 + fr, fq * 8), boff = lds_byte(wc * 32 + fr, fq * 8);
#define PG8_SA(b, h) (((b) * 2 + (h)) * HTB)
#define PG8_SB(b, h) ((4 + (b) * 2 + (h)) * HTB)
#define PG8_STAGE(bufoff, gbase, voff) do { _Pragma("unroll") for (int _i = 0; _i < 2; ++_i) \
        __builtin_amdgcn_global_load_lds((const unsigned*)((const char*)(gbase) + (voff)[_i]), (PG8_LAS unsigned*)(lds + (bufoff) + ldsw + _i * 8192), 16, 0, 0); } while (0)
#define PG8_LDA(dst, b, h) do { _Pragma("unroll") for (int m = 0; m < 4; ++m) _Pragma("unroll") for (int k = 0; k < 2; ++k) dst[m][k] = *(const PG8_LAS bf16x8*)(lds + PG8_SA(b, h) + aoff + m * 2048 + k * 1024); } while (0)
#define PG8_LDB(dst, b, h) do { _Pragma("unroll") for (int n = 0; n < 2; ++n) _Pragma("unroll") for (int k = 0; k < 2; ++k) dst[n][k] = *(const PG8_LAS bf16x8*)(lds + PG8_SB(b, h) + boff + n * 2048 + k * 1024); } while (0)
#define PG8_MMA(ai, bj, At, Bt) do { __builtin_amdgcn_s_setprio(1); _Pragma("unroll") for (int m = 0; m < 4; ++m) _Pragma("unroll") for (int n = 0; n < 2; ++n) _Pragma("unroll") for (int k = 0; k < 2; ++k) \
        acc[ai][bj][m][n] = __builtin_amdgcn_mfma_f32_16x16x32_bf16(Bt[n][k], At[m][k], acc[ai][bj][m][n], 0, 0, 0); __builtin_amdgcn_s_setprio(0); } while (0)
#define PG8_WAIT_V(n) asm volatile("s_waitcnt vmcnt(" #n ")" ::: "memory")
#define PG8_WAIT_L(n) asm volatile("s_waitcnt lgkmcnt(" #n ")" ::: "memory")
#define PG8_BAR __builtin_amdgcn_s_barrier()
#define PG8_SCHED __builtin_amdgcn_sched_barrier(0)
    Unit cur, nxt; int ui = 0;
    if (!S.next(0, cur)) return;
    f32x4 acc[2][2][4][2];
#pragma unroll
    for (int a = 0; a < 2; ++a)
#pragma unroll
        for (int b = 0; b < 2; ++b)
#pragma unroll
            for (int m = 0; m < 4; ++m)
#pragma unroll
                for (int n = 0; n < 2; ++n) acc[a][b][m][n] = (f32x4){0.f, 0.f, 0.f, 0.f};
    bf16x8 At[4][2], B0[2][2], B1[2][2];
    const char* cA = (const char*)g.A + (size_t)cur.pm * tstepA + (size_t)cur.pn * apn; const char* cB = (const char*)g.Bt + (size_t)cur.pn * tstepB;
    S.a_ready(cur);
    if constexpr (SP2) {
        PG8_STAGE(PG8_SB(0, 0), cB, voffB); PG8_STAGE(PG8_SB(0, 1), cB + hstepB, voffB); PG8_STAGE(PG8_SA(0, 0), cA, voffA); PG8_STAGE(PG8_SA(0, 1), cA + hstepA, voffA);
        if (wr == 1) PG8_BAR;
        PG8_WAIT_V(2); PG8_BAR;
        PG8_STAGE(PG8_SB(1, 0), cB + kstep, voffB); PG8_STAGE(PG8_SA(1, 0), cA + kstep, voffA); PG8_STAGE(PG8_SB(1, 1), cB + hstepB + kstep, voffB);
        PG8_WAIT_V(6); PG8_BAR;
    } else {
        PG8_STAGE(PG8_SB(0, 0), cB, voffB); PG8_STAGE(PG8_SA(0, 0), cA, voffA); PG8_STAGE(PG8_SB(0, 1), cB + hstepB, voffB); PG8_STAGE(PG8_SA(0, 1), cA + hstepA, voffA);
        if (wr == 1) PG8_BAR;
        PG8_WAIT_V(4); PG8_BAR;
        PG8_STAGE(PG8_SB(1, 0), cB + kstep, voffB); PG8_STAGE(PG8_SA(1, 0), cA + kstep, voffA); PG8_STAGE(PG8_SB(1, 1), cB + hstepB + kstep, voffB);
        PG8_WAIT_V(6); PG8_BAR;
    }
    for (;;) {
        const bool has_next = S.next(ui + 1, nxt);
        const char* nA = has_next ? (const char*)g.A + (size_t)nxt.pm * tstepA + (size_t)nxt.pn * apn : cA; const char* nB = has_next ? (const char*)g.Bt + (size_t)nxt.pn * tstepB : cB;
        for (int t = 0; t < nt; t += 2) {
            const bool last = (t == nt - 2);
            const char* a1 = cA + (size_t)(t + 1) * kstep;
            const char* a2 = last ? nA : cA + (size_t)(t + 2) * kstep; const char* b2 = last ? nB : cB + (size_t)(t + 2) * kstep;
            const char* a3 = a2 + kstep; const char* b3 = b2 + kstep;
            if (last && has_next) S.a_ready(nxt);
            if constexpr (SP2) {
            PG8_LDB(B0, 0, 0); PG8_LDB(B1, 0, 1); PG8_SCHED; PG8_LDA(At, 0, 0); PG8_STAGE(PG8_SA(1, 1), a1 + hstepA, voffA);
            PG8_WAIT_V(8); PG8_WAIT_L(0); PG8_BAR; PG8_MMA(0, 0, At, B0); PG8_MMA(0, 1, At, B1); PG8_BAR; PG8_SCHED;
            PG8_LDA(At, 0, 1); PG8_STAGE(PG8_SB(0, 0), b2, voffB); PG8_STAGE(PG8_SB(0, 1), b2 + hstepB, voffB); PG8_STAGE(PG8_SA(0, 0), a2, voffA);
            PG8_WAIT_V(8); PG8_WAIT_L(0); PG8_BAR; PG8_MMA(1, 0, At, B0); PG8_MMA(1, 1, At, B1); PG8_BAR; PG8_SCHED;
            PG8_LDB(B0, 1, 0); PG8_LDB(B1, 1, 1); PG8_SCHED; PG8_LDA(At, 1, 0); PG8_STAGE(PG8_SA(0, 1), a2 + hstepA, voffA);
            PG8_WAIT_V(8); PG8_WAIT_L(0); PG8_BAR; PG8_MMA(0, 0, At, B0); PG8_MMA(0, 1, At, B1); PG8_BAR; PG8_SCHED;
            PG8_LDA(At, 1, 1); PG8_STAGE(PG8_SB(1, 0), b3, voffB); PG8_STAGE(PG8_SB(1, 1), b3 + hstepB, voffB); PG8_STAGE(PG8_SA(1, 0), a3, voffA);
            PG8_WAIT_V(8); PG8_WAIT_L(0); PG8_BAR; PG8_MMA(1, 0, At, B0); PG8_MMA(1, 1, At, B1); PG8_BAR; PG8_SCHED;
            } else {
            PG8_LDB(B0, 0, 0); PG8_SCHED; PG8_LDA(At, 0, 0); PG8_STAGE(PG8_SA(1, 1), a1 + hstepA, voffA);
            PG8_WAIT_L(8); PG8_BAR; PG8_WAIT_L(0); PG8_MMA(0, 0, At, B0); PG8_BAR; PG8_SCHED;
            PG8_LDB(B1, 0, 1); PG8_STAGE(PG8_SB(0, 0), b2, voffB);
            PG8_BAR; PG8_WAIT_L(0); PG8_MMA(0, 1, At, B1); PG8_BAR;
            PG8_LDA(At, 0, 1); PG8_STAGE(PG8_SA(0, 0), a2, voffA);
            PG8_BAR; PG8_WAIT_L(0); PG8_MMA(1, 0, At, B0); PG8_BAR; PG8_SCHED;
            PG8_STAGE(PG8_SB(0, 1), b2 + hstepB, voffB);
            PG8_WAIT_V(6); PG8_BAR; PG8_MMA(1, 1, At, B1); PG8_BAR;
            PG8_LDB(B0, 1, 0); PG8_SCHED; PG8_LDA(At, 1, 0); PG8_STAGE(PG8_SA(0, 1), a2 + hstepA, voffA);
            PG8_WAIT_L(8); PG8_BAR; PG8_WAIT_L(0); PG8_MMA(0, 0, At, B0); PG8_BAR; PG8_SCHED;
            PG8_LDB(B1, 1, 1); PG8_STAGE(PG8_SB(1, 0), b3, voffB);
            PG8_BAR; PG8_WAIT_L(0); PG8_MMA(0, 1, At, B1); PG8_BAR;
            PG8_LDA(At, 1, 1); PG8_STAGE(PG8_SA(1, 0), a3, voffA);
            PG8_BAR; PG8_WAIT_L(0); PG8_MMA(1, 0, At, B0); PG8_BAR; PG8_SCHED;
            PG8_STAGE(PG8_SB(1, 1), b3 + hstepB, voffB);
            PG8_WAIT_V(6); PG8_BAR; PG8_MMA(1, 1, At, B1); PG8_BAR;
            }
        }
        if constexpr (ALIGN_EPI) { if (wr == 0) PG8_BAR; }
        if constexpr (!Epi::AFTER_DRAIN) { E(acc, cur, wr, wc, fr, fq); S.done(cur); }
        if (!has_next) break;
#pragma unroll
        for (int a = 0; a < 2; ++a)
#pragma unroll
            for (int b = 0; b < 2; ++b)
#pragma unroll
                for (int m = 0; m < 4; ++m)
#pragma unroll
                    for (int n = 0; n < 2; ++n) acc[a][b][m][n] = (f32x4){0.f, 0.f, 0.f, 0.f};
        cur = nxt; cA = nA; cB = nB; ++ui;
        if constexpr (ALIGN_EPI) { if (wr == 1) PG8_BAR; }
    }
    PG8_WAIT_V(0);
    if constexpr (!ALIGN_EPI) { if (wr == 0) PG8_BAR; }
    PG8_BAR;
    if constexpr (Epi::AFTER_DRAIN) { E.fused(acc, cur, wr, wc, fr, fq, lds, wid, lane); S.done(cur); }
#undef PG8_SA
#undef PG8_SB
#undef PG8_STAGE
#undef PG8_LDA
#undef PG8_LDB
#undef PG8_MMA
#undef PG8_WAIT_V
#undef PG8_WAIT_L
#undef PG8_BAR
#undef PG8_SCHED
}
}
#include <hip/hip_bf16.h>
#include <cmath>
namespace attn_body {
using bf16=__hip_bfloat16;
using bf16x8=__attribute__((ext_vector_type(8)))short;
using s16x4=__attribute__((ext_vector_type(4)))short;
using f32x16=__attribute__((ext_vector_type(16)))float;
using u32x4=__attribute__((ext_vector_type(4)))unsigned;
constexpr int BATCH=4,NHEAD=32,SEQ=4096,D=64,PQ=1024,PO=2048;
constexpr int NW=8,QBLK=32,QB=QBLK*NW,KVBLK=64,NQB=SEQ/QB;
constexpr int ATTN_UNIT_ROWS=QB;
__device__ __forceinline__ int crow(int r,int hi){return (r&3)+8*(r>>2)+4*hi;}
#define SBAR() __builtin_amdgcn_sched_barrier(0)
__device__ __forceinline__ void cmask(f32x16&p0,f32x16&p1,int jb,int qrel,int hi){
  const float NEG=-INFINITY; int kb=64*jb+4*hi;
  #pragma unroll
  for(int r=0;r<16;++r){int kv=kb+(r&3)+8*(r>>2); if(kv>qrel)p0[r]=NEG; if(kv+32>qrel)p1[r]=NEG;}
}

constexpr int NSLOT=3, SLOTB=8192;
constexpr int LDS_K=0, LDS_V=NSLOT*SLOTB, LDS_WS=2*NSLOT*SLOTB, LDS_OST=LDS_WS+NW*64*4, LDS_BYTES=LDS_OST+NW*4096;
constexpr float C2=0.125f*1.4426950408889634f;
__device__ __forceinline__ void glds16(const void*gsrc,unsigned lds_dst){unsigned keep;
  asm volatile("s_mov_b32 %0, m0\n\ts_mov_b32 m0, %2\n\ts_nop 0\n\tglobal_load_lds_dwordx4 %1, off\n\ts_mov_b32 m0, %0":"=&s"(keep):"v"(gsrc),"s"(lds_dst):"memory");}
__device__ __forceinline__ float max3f(float a,float b,float c){float r;asm("v_max3_f32 %0, %1, %2, %3":"=v"(r):"v"(a),"v"(b),"v"(c));return r;}
__device__ __forceinline__ float max2f(float a,float b){float r;asm("v_max_f32_e32 %0, %1, %2":"=v"(r):"v"(a),"v"(b));return r;}
__device__ __forceinline__ float fadd_s(float a,float b){float r;asm("v_add_f32_e32 %0, %1, %2":"=v"(r):"v"(a),"v"(b));return r;}
__device__ __forceinline__ float fsub_s(float a,float b){float r;asm("v_sub_f32_e32 %0, %1, %2":"=v"(r):"v"(a),"v"(b));return r;}
typedef float f32x2_t __attribute__((ext_vector_type(2))); typedef __bf16 bf16x2_t __attribute__((ext_vector_type(2)));
__device__ __forceinline__ unsigned cvtpk_s(float lo,float hi){f32x2_t v={lo,hi};bf16x2_t b=__builtin_convertvector(v,bf16x2_t);return __builtin_bit_cast(unsigned,b);}
#define WAIT_BAR(N) asm volatile("s_waitcnt vmcnt(" #N ") lgkmcnt(0)\n\ts_barrier":::"memory")

__device__ __forceinline__ void qkt(f32x16&p0,f32x16&p1,const char*Kslot,const bf16x8*qr,const f32x16&negm,int r32,int hi){
  const char*kb=Kslot+hi*1024+r32*16;
  #pragma unroll
  for(int d0=0;d0<4;++d0){
    const bf16x8 b0=*reinterpret_cast<const bf16x8*>(kb+d0*2048);
    const bf16x8 b1=*reinterpret_cast<const bf16x8*>(kb+d0*2048+512);
    if(d0==0){p0=__builtin_amdgcn_mfma_f32_32x32x16_bf16(b0,qr[0],negm,0,0,0);p1=__builtin_amdgcn_mfma_f32_32x32x16_bf16(b1,qr[0],negm,0,0,0);}
    else{p0=__builtin_amdgcn_mfma_f32_32x32x16_bf16(b0,qr[d0],p0,0,0,0);p1=__builtin_amdgcn_mfma_f32_32x32x16_bf16(b1,qr[d0],p1,0,0,0);}}
}
typedef __attribute__((address_space(3))) const char* lds_cptr;
typedef short v4i16_t __attribute__((ext_vector_type(4)));
__device__ __forceinline__ void kload8(bf16x8*kf,lds_cptr kp){
  kf[0]=*(const __attribute__((address_space(3))) bf16x8*)(kp);      kf[1]=*(const __attribute__((address_space(3))) bf16x8*)(kp+512);
  kf[2]=*(const __attribute__((address_space(3))) bf16x8*)(kp+2048); kf[3]=*(const __attribute__((address_space(3))) bf16x8*)(kp+2560);
  kf[4]=*(const __attribute__((address_space(3))) bf16x8*)(kp+4096); kf[5]=*(const __attribute__((address_space(3))) bf16x8*)(kp+4608);
  kf[6]=*(const __attribute__((address_space(3))) bf16x8*)(kp+6144); kf[7]=*(const __attribute__((address_space(3))) bf16x8*)(kp+6656);
}
__device__ __forceinline__ void kload2(bf16x8*kf,lds_cptr kp,int j){ kf[2*j]=*(const __attribute__((address_space(3))) bf16x8*)(kp+j*2048); kf[2*j+1]=*(const __attribute__((address_space(3))) bf16x8*)(kp+j*2048+512); }
__device__ __forceinline__ s16x4 vtr(lds_cptr p){ return __builtin_bit_cast(s16x4,__builtin_amdgcn_ds_read_tr16_b64_v4i16((__attribute__((address_space(3))) v4i16_t*)p)); }
__device__ __forceinline__ float rowmax(const f32x16&p0,const f32x16&p1){
  float a=max3f(p0[0],p0[1],p1[0]),b=max3f(p0[2],p0[3],p1[1]);a=max3f(a,p1[2],p1[3]);
  #pragma unroll
  for(int r=4;r<16;r+=4){a=max3f(a,p0[r],p0[r+1]);b=max3f(b,p0[r+2],p0[r+3]);a=max3f(a,p1[r],p1[r+1]);b=max3f(b,p1[r+2],p1[r+3]);}
  const float m=max2f(a,b);
  auto rr=__builtin_amdgcn_permlane32_swap(__float_as_uint(m),__float_as_uint(m),false,false);
  return max2f(__uint_as_float(rr[0]),__uint_as_float(rr[1]));
}
__device__ __forceinline__ void pv(f32x16*o,int vb,bf16x8 pa0,bf16x8 pa1,bf16x8 pa2,bf16x8 pa3){
  #pragma unroll
  for(int d0=0;d0<2;++d0){s16x4 lo[4],hi[4];
    #pragma unroll
    for(int ks=0;ks<4;++ks){
      asm volatile("ds_read_b64_tr_b16 %0,%1 offset:%c2":"=&v"(lo[ks]):"v"(vb),"i"(d0*4096+ks*1024):"memory");
      asm volatile("ds_read_b64_tr_b16 %0,%1 offset:%c2":"=&v"(hi[ks]):"v"(vb),"i"(d0*4096+ks*1024+512):"memory");}
    asm volatile("s_waitcnt lgkmcnt(0)":::"memory");SBAR();
    #define PK(k) (bf16x8){lo[k][0],lo[k][1],lo[k][2],lo[k][3],hi[k][0],hi[k][1],hi[k][2],hi[k][3]}
    o[d0]=__builtin_amdgcn_mfma_f32_32x32x16_bf16(pa0,PK(0),o[d0],0,0,0);
    o[d0]=__builtin_amdgcn_mfma_f32_32x32x16_bf16(pa1,PK(1),o[d0],0,0,0);
    o[d0]=__builtin_amdgcn_mfma_f32_32x32x16_bf16(pa2,PK(2),o[d0],0,0,0);
    o[d0]=__builtin_amdgcn_mfma_f32_32x32x16_bf16(pa3,PK(3),o[d0],0,0,0);
    #undef PK
  }
}

#ifndef ATTN_STORE16
#define ATTN_STORE16(p,v) (*(u32x4*)(p)=(v))
#endif
template<int THRL> __device__ __forceinline__ void attn_unit(int b,int vh,int qb,const bf16*Q,const bf16*__restrict__ K,const bf16*__restrict__ V,bf16*O,char*shm){
  int tid_=threadIdx.x; asm volatile("":"+v"(tid_)); const int tid=tid_,lane=tid&63,r32=lane&31,hi=lane>>5; const int wid=__builtin_amdgcn_readfirstlane(tid>>6);
  const long rowbase=(long)b*SEQ; const int q0=qb*QB;
  const int qcol=(vh>>2)*128+((vh>>1)&1)*64, vcol=(vh>>2)*128+(vh&1)*64, ocol=vh*64;
  const bf16*Qw=Q+(rowbase+q0+wid*QBLK)*PQ+qcol;
  const bf16*Kh=K+rowbase*PQ+qcol,*Vh=V+rowbase*PQ+vcol;
  const unsigned lds0=(unsigned)(uintptr_t)shm;
  float*wsf=(float*)(shm+LDS_WS)+wid*64;
  const bf16*ksrc=Kh+(long)lane*PQ+wid*8;
  const bf16*vsrc=Vh+(long)(16*(wid&3)+(lane>>2))*PQ+(wid>>2)*32+(lane&3)*8;
  const unsigned kdst=lds0+LDS_K+wid*1024, vdst=lds0+LDS_V+wid*1024;
  #define DMA_K(t,slot) glds16(ksrc+(long)(t)*KVBLK*PQ,(unsigned)__builtin_amdgcn_readfirstlane(kdst+(slot)))
  #define DMA_V(t,slot) glds16(vsrc+(long)(t)*KVBLK*PQ,(unsigned)__builtin_amdgcn_readfirstlane(vdst+(slot)))
  const int vb0=(int)(lds0+LDS_V)+((lane>>4)&1)*32+(lane&3)*8+(4*hi+((lane&15)>>2))*64;
  const char*Kbase=shm+LDS_K; bf16x8 kf[8];
  const lds_cptr shm3=(lds_cptr)shm; const lds_cptr kp0=shm3+LDS_K+hi*1024+r32*16; const lds_cptr vp0=shm3+LDS_V+((lane>>4)&1)*32+(lane&3)*8+(4*hi+((lane&15)>>2))*64;
  const int NT=(q0+QB)/KVBLK;
  DMA_K(0,0);DMA_V(0,0);DMA_K(1,SLOTB);
  bf16x8 qr[4];
  #pragma unroll
  for(int d0=0;d0<4;++d0)qr[d0]=*reinterpret_cast<const bf16x8*>(&Qw[(long)r32*PQ+d0*16+hi*8]);
  float mhat=0.f,l_reg=0.f;f32x16 o[2];o[0]=f32x16{};o[1]=f32x16{};f32x16 negm=f32x16{};asm volatile("":"+v"(negm));
  const int qrel=wid*QBLK+r32;
  #define CMASK(P0,P1,t) do{int jb_=(t)-(NT-4); if(jb_>=0)cmask(P0,P1,jb_,qrel,hi);}while(0)
  bool resc=false;
  #define START(P0,P1) do{ const float rm=rowmax(P0,P1); resc=false; \
    { const float dl=rm; mhat=fadd_s(mhat,dl); \
      _Pragma("unroll") for(int r=0;r<16;++r){P0[r]=fsub_s(P0[r],dl);P1[r]=fsub_s(P1[r],dl);} \
      _Pragma("unroll") for(int r=0;r<16;++r)negm[r]=-mhat; asm volatile("":"+v"(negm)); } \
    _Pragma("unroll") for(int r=0;r<16;++r)P0[r]=__builtin_amdgcn_exp2f(P0[r]); }while(0)
  #define RESC() do{ if(resc){ asm volatile("s_waitcnt lgkmcnt(0)":::"memory"); \
      _Pragma("unroll") for(int d_=0;d_<2;++d_) _Pragma("unroll") for(int r=0;r<16;++r)o[d_][r]*=wsf[crow(r,hi)]; } }while(0)
  f32x16 pA0,pA1,pB0,pB1;
  int sl_prev=0,sl_cur=0,sl_next=SLOTB;
  #define ROT() do{sl_prev=sl_cur;sl_cur=sl_next;sl_next=(sl_next==(NSLOT-1)*SLOTB)?0:sl_next+SLOTB;}while(0)
  DMA_K(2,2*SLOTB);
  WAIT_BAR(3);
  qkt(pA0,pA1,Kbase,qr,negm,r32,hi);asm volatile("s_nop 15\n\ts_nop 7":"+v"(pA0),"+v"(pA1));CMASK(pA0,pA1,0);
  START(pA0,pA1);
  _Pragma("unroll") for(int r=0;r<16;++r)pA1[r]=__builtin_amdgcn_exp2f(pA1[r]);
  WAIT_BAR(0);
  DMA_K(3,0);DMA_V(1,SLOTB);
  ROT();
  kload8(kf,kp0+sl_cur);
  WAIT_BAR(2);
  s16x4 vlo[8],vhi[8]; u32x4 pw0,pw1,pw2,pw3;
  #define PKW(P,B) cvtpk_s(P[B],P[B+1])
  #define PAF(k) __builtin_bit_cast(bf16x8,pw##k)
  #define VFR(i) (bf16x8){vlo[i][0],vlo[i][1],vlo[i][2],vlo[i][3],vhi[i][0],vhi[i][1],vhi[i][2],vhi[i][3]}
  #define PIN(x) asm volatile("":"+v"(x))
  #define MX3(a,b,c) __builtin_fmaxf(__builtin_fmaxf((a),(b)),(c))
  #define GAPA(MF,A0,A1,A2,A3,W0,W1,PW) do{ MF; sacc+=A0; sacc+=A1; sacc+=A2; sacc+=A3; PIN(sacc); W0; W1; PIN(PW); SBAR(); }while(0)
  #define EX(v) __builtin_amdgcn_exp2f(v)
  #define GAPB(MF,X,B) do{ MF; X[B]=EX(X[B]); X[B+1]=EX(X[B+1]); X[B+2]=EX(X[B+2]); X[B+3]=EX(X[B+3]); PIN(X); SBAR(); }while(0)
  #define VRD(i) do{ vlo[i]=vtr(vp_+(((i)>>2)*4096+((i)&3)*1024)); vhi[i]=vtr(vp_+(((i)>>2)*4096+((i)&3)*1024+512)); }while(0)
  #define KRD(G,j) do{ if(G){ kload2(kf,kp0+sl_next,j); SBAR(); } }while(0)
  #define STEP(C0,C1,P0,P1,t,GK,GV,GL) do{ SBAR(); \
    const lds_cptr vp_=vp0+sl_prev; \
    VRD(0); SBAR(); float sacc=(P0[0]+P0[1]); \
    GAPA(C0=__builtin_amdgcn_mfma_f32_32x32x16_bf16(kf[0],qr[0],negm,0,0,0), P0[2],P0[3],P0[4],P0[5],     pw0[0]=PKW(P0,0), pw0[1]=PKW(P0,2), pw0); \
    VRD(4); SBAR(); GAPA(C1=__builtin_amdgcn_mfma_f32_32x32x16_bf16(kf[1],qr[0],negm,0,0,0), P0[6],P0[7],P0[8],P0[9],     pw0[2]=PKW(P0,4), pw0[3]=PKW(P0,6), pw0); \
    VRD(1); SBAR(); GAPA(C0=__builtin_amdgcn_mfma_f32_32x32x16_bf16(kf[2],qr[1],C0,0,0,0),   P0[10],P0[11],P0[12],P0[13], pw1[0]=PKW(P0,8), pw1[1]=PKW(P0,10), pw1); \
    VRD(5); SBAR(); GAPA(C1=__builtin_amdgcn_mfma_f32_32x32x16_bf16(kf[3],qr[1],C1,0,0,0),   P0[14],P0[15],P1[0],P1[1],   pw1[2]=PKW(P0,12),pw1[3]=PKW(P0,14), pw1); \
    VRD(2); SBAR(); GAPA(C0=__builtin_amdgcn_mfma_f32_32x32x16_bf16(kf[4],qr[2],C0,0,0,0),   P1[2],P1[3],P1[4],P1[5],     pw2[0]=PKW(P1,0), pw2[1]=PKW(P1,2), pw2); \
    VRD(6); SBAR(); GAPA(C1=__builtin_amdgcn_mfma_f32_32x32x16_bf16(kf[5],qr[2],C1,0,0,0),   P1[6],P1[7],P1[8],P1[9],     pw2[2]=PKW(P1,4), pw2[3]=PKW(P1,6), pw2); \
    VRD(3); SBAR(); GAPA(C0=__builtin_amdgcn_mfma_f32_32x32x16_bf16(kf[6],qr[3],C0,0,0,0),   P1[10],P1[11],P1[12],P1[13], pw3[0]=PKW(P1,8), pw3[1]=PKW(P1,10), pw3); \
    VRD(7); SBAR(); GAPA(C1=__builtin_amdgcn_mfma_f32_32x32x16_bf16(kf[7],qr[3],C1,0,0,0),   P1[14],P1[15],0.f,0.f,       pw3[2]=PKW(P1,12),pw3[3]=PKW(P1,14), pw3); \
    l_reg+=sacc; \
    if(GK){DMA_K((t)+3,sl_cur);} if(GV){DMA_V((t)+1,sl_next);} \
    CMASK(C0,C1,t); \
    { float a=MX3(C0[0],C0[1],C1[0]),b=MX3(C0[2],C0[3],C1[1]); a=MX3(a,C1[2],C1[3]); \
      _Pragma("unroll") for(int r=4;r<16;r+=4){a=MX3(a,C0[r],C0[r+1]);b=MX3(b,C0[r+2],C0[r+3]);a=MX3(a,C1[r],C1[r+1]);b=MX3(b,C1[r+2],C1[r+3]);} \
      float rm=__builtin_fmaxf(a,b); { auto rr=__builtin_amdgcn_permlane32_swap(__float_as_uint(rm),__float_as_uint(rm),false,false); rm=__builtin_fmaxf(__uint_as_float(rr[0]),__uint_as_float(rr[1])); } \
      resc=false; \
      if(__builtin_expect(__any(rm>(float)THRL),0)){ const float dl=__builtin_fmaxf(rm,0.f); mhat+=dl; \
        _Pragma("unroll") for(int r=0;r<16;++r){C0[r]-=dl;C1[r]-=dl;} \
        _Pragma("unroll") for(int r=0;r<16;++r)negm[r]=-mhat; asm volatile("":"+v"(negm)); \
        const float f=__builtin_amdgcn_exp2f(-dl); l_reg*=f; if(hi==0)wsf[r32]=f; resc=true; } } \
    SBAR(); \
    GAPB(o[0]=__builtin_amdgcn_mfma_f32_32x32x16_bf16(PAF(0),VFR(0),o[0],0,0,0), C0,0); \
    GAPB(o[1]=__builtin_amdgcn_mfma_f32_32x32x16_bf16(PAF(0),VFR(4),o[1],0,0,0), C0,4); \
    KRD(GL,0); GAPB(o[0]=__builtin_amdgcn_mfma_f32_32x32x16_bf16(PAF(1),VFR(1),o[0],0,0,0), C0,8); \
    KRD(GL,1); GAPB(o[1]=__builtin_amdgcn_mfma_f32_32x32x16_bf16(PAF(1),VFR(5),o[1],0,0,0), C0,12); \
    KRD(GL,2); GAPB(o[0]=__builtin_amdgcn_mfma_f32_32x32x16_bf16(PAF(2),VFR(2),o[0],0,0,0), C1,0); \
    KRD(GL,3); GAPB(o[1]=__builtin_amdgcn_mfma_f32_32x32x16_bf16(PAF(2),VFR(6),o[1],0,0,0), C1,4); \
    GAPB(o[0]=__builtin_amdgcn_mfma_f32_32x32x16_bf16(PAF(3),VFR(3),o[0],0,0,0), C1,8); \
    GAPB(o[1]=__builtin_amdgcn_mfma_f32_32x32x16_bf16(PAF(3),VFR(7),o[1],0,0,0), C1,12); \
    }while(0)
  int t=1;
  #undef CMASK
  #define CMASK(P0,P1,t) do{}while(0)
  for(;t+5<NT;t+=2){
    STEP(pB0,pB1,pA0,pA1,t,true,true,true);     WAIT_BAR(2); RESC(); ROT();
    STEP(pA0,pA1,pB0,pB1,t+1,true,true,true);   WAIT_BAR(2); RESC(); ROT();
  }
  #undef CMASK
  #define CMASK(P0,P1,t) do{int jb_=(t)-(NT-4); if(jb_>=0)cmask(P0,P1,jb_,qrel,hi);}while(0)
  #define ENDW(tt) do{ if((tt)+3<NT){WAIT_BAR(2);} else if((tt)+2<NT){WAIT_BAR(1);} else {WAIT_BAR(0);} }while(0)
  for(;t+1<NT;t+=2){
    STEP(pB0,pB1,pA0,pA1,t,(t+3<NT),(t+1<NT),(t+1<NT));       ENDW(t);   RESC(); ROT();
    STEP(pA0,pA1,pB0,pB1,t+1,(t+4<NT),(t+2<NT),(t+2<NT));     ENDW(t+1); RESC(); ROT();
  }
  STEP(pB0,pB1,pA0,pA1,NT-1,false,false,false); RESC();
  { float sacc=pB0[0]+pB0[1]; _Pragma("unroll") for(int r=2;r<16;++r)sacc+=pB0[r]; _Pragma("unroll") for(int r=0;r<16;++r)sacc+=pB1[r]; l_reg+=sacc;
    pw0=(u32x4){PKW(pB0,0),PKW(pB0,2),PKW(pB0,4),PKW(pB0,6)};pw1=(u32x4){PKW(pB0,8),PKW(pB0,10),PKW(pB0,12),PKW(pB0,14)};pw2=(u32x4){PKW(pB1,0),PKW(pB1,2),PKW(pB1,4),PKW(pB1,6)};pw3=(u32x4){PKW(pB1,8),PKW(pB1,10),PKW(pB1,12),PKW(pB1,14)};
    SBAR(); pv(o,vb0+sl_cur,PAF(0),PAF(1),PAF(2),PAF(3)); }
  #undef PKW
  #undef PAF
  #undef VFR
  #undef PIN
  #undef MX3
  #undef GAPA
  #undef GAPB
  #undef EX
  #undef VRD
  #undef KRD
  #undef STEP
  #undef ENDW
  {auto rr=__builtin_amdgcn_permlane32_swap(__float_as_uint(l_reg),__float_as_uint(l_reg),false,false);l_reg=__uint_as_float(rr[0])+__uint_as_float(rr[1]);}
  if(hi==0)wsf[32+r32]=l_reg;asm volatile("s_waitcnt lgkmcnt(0)":::"memory");
  float rli[16];
  #pragma unroll
  for(int r=0;r<16;++r)rli[r]=__builtin_amdgcn_rcpf(wsf[32+crow(r,hi)]);
  bf16*Ow=O+(rowbase+q0+wid*QBLK)*PO+ocol;
  { bf16*stg=(bf16*)(shm+LDS_OST)+wid*2048;
    #pragma unroll
    for(int r=0;r<16;++r){const int orow=crow(r,hi);
      #pragma unroll
      for(int d0=0;d0<2;++d0)stg[orow*64+d0*32+r32]=__float2bfloat16(o[d0][r]*rli[r]);}
    asm volatile("s_waitcnt lgkmcnt(0)":::"memory");
    #pragma unroll
    for(int i=0;i<4;++i){const int row=i*8+(lane>>3),ch=lane&7; const u32x4 v=*(const u32x4*)(stg+row*64+ch*8); ATTN_STORE16(Ow+(long)row*PO+ch*8,v);} }
  asm volatile("s_waitcnt lgkmcnt(0)\n\ts_barrier":::"memory");
  #undef DMA_K
  #undef DMA_V
  #undef CMASK
  #undef START
  #undef RESC
  #undef ROT
}
constexpr int ATTN_LDS_BYTES=LDS_BYTES;
struct AttnTensors { const bf16* Q; const bf16* K; const bf16* V; bf16* O; };
struct AttnUnit { int bh; int qb; };
struct StaticOrder {
  int vcu, G;
  __device__ __forceinline__ explicit StaticOrder(int grid,int block):vcu((grid%8==0)?(block%8)*(grid/8)+block/8:block),G(grid){}
  __device__ __forceinline__ bool next(int i,AttnUnit&u)const{
    if(G==256){ if(i>=8)return false; const int s=vcu&1; u.bh=vcu>>1; u.qb=2*i+((i&1)^s); return true; }
    const int L=i*G+vcu; if(L>=BATCH*NHEAD*NQB)return false; u.bh=L/NQB; u.qb=NQB-1-(L%NQB); return true; }
  __device__ __forceinline__ void a_ready(const AttnUnit&)const{}
  __device__ __forceinline__ void done(const AttnUnit&)const{}
};
template<class Sched,int THRL=8> __device__ __forceinline__ void attn_phase(char*lds,const AttnTensors&T,const Sched&S){
  AttnUnit u;
  for(int i=0;S.next(i,u);++i){ S.a_ready(u); attn_unit<THRL>(u.bh/NHEAD,u.bh%NHEAD,u.qb,T.Q,T.K,T.V,T.O,lds); S.done(u); }
}
#undef SBAR
#undef WAIT_BAR
}
namespace cg = cooperative_groups;
#ifndef PG_ALIGN
#define PG_ALIGN true
#endif
#ifndef PG_SP2
#define PG_SP2 true
#endif
constexpr int NWAVES = 8;
constexpr int BATCH = 4, SEQ = 4096, DMODEL = 1024, DIN = 2048, INCOLS = 6144, M = BATCH * SEQ;
constexpr size_t MiB = 1u << 20;
constexpr size_t WS_WIN = 1 * MiB;
constexpr size_t WS_WOUT = 13 * MiB;
constexpr size_t WS_POOLW = 17 * MiB;
constexpr size_t WS_ROPE = 17 * MiB + 512 * 1024;
constexpr size_t WS_A = 19 * MiB;
constexpr size_t WS_Q = 51 * MiB, WS_K = 83 * MiB, WS_V = 115 * MiB;
constexpr size_t WS_Y = 51 * MiB;
constexpr size_t WS_XN = 147 * MiB;
constexpr size_t WS_O = 179 * MiB;
constexpr size_t WS_OUT0 = 179 * MiB;
constexpr size_t WS_STATS = 51 * MiB;
constexpr size_t WS_U = 56 * MiB, WS_V1 = 120 * MiB, WS_G1 = 184 * MiB;
constexpr size_t WS_OUT1 = 120 * MiB;
constexpr size_t WS_END = 248 * MiB;
constexpr int LDS_BYTES = 147456;
#define GAS __attribute__((address_space(1)))
#define LAS __attribute__((address_space(3)))
typedef unsigned short bf16;
typedef unsigned v4u __attribute__((ext_vector_type(4)));
typedef unsigned v2u __attribute__((ext_vector_type(2)));
typedef float f32x4 __attribute__((ext_vector_type(4)));
typedef short bf16x8 __attribute__((ext_vector_type(8)));
#define LDS_WAIT() asm volatile("s_waitcnt lgkmcnt(0)" ::: "memory")
__device__ __forceinline__ unsigned f2bf(float f) { unsigned u = __builtin_bit_cast(unsigned, f); return (u + 0x7fffu + ((u >> 16) & 1u)) >> 16; }
__device__ __forceinline__ unsigned pk2(float lo, float hi) { return pg8::cvt_pk_bf16(lo, hi); }
__device__ __forceinline__ float bflo(unsigned w) { return __uint_as_float(w << 16); }
__device__ __forceinline__ float bfhi(unsigned w) { return __uint_as_float(w & 0xffff0000u); }
__device__ __forceinline__ float wave_sum(float v) {
    v += pg8::swz_xor<1>(v); v += pg8::swz_xor<2>(v); v += pg8::swz_xor<4>(v); v += pg8::swz_xor<8>(v); v += pg8::swz_xor<16>(v);
    return pg8::half_sum(v);
}
struct Frame { LAS unsigned char* lds; int tid, lane, wave, vcu, G; };
__device__ __forceinline__ unsigned long long ldp(LAS unsigned long long* PT, int k) { asm volatile("" ::: "memory"); const unsigned long long v = PT[k]; const unsigned lo = __builtin_amdgcn_readfirstlane((unsigned)v), hi = __builtin_amdgcn_readfirstlane((unsigned)(v >> 32)); return ((unsigned long long)hi << 32) | lo; }

__device__ __forceinline__ void p0_transpose_item(const float* W, int K, int N, bf16* WT, int row_off, LAS float* scr, int item, int lane) {
    const int nblk = N / 32, kb = item / nblk, nb = item % nblk, k0 = 64 * kb, n0 = 32 * nb;
#pragma unroll 8
    for (int i = 0; i < 32; ++i) { const int kk = 2 * i + (lane >> 5); scr[kk * 33 + (lane & 31)] = W[(size_t)(k0 + kk) * N + n0 + (lane & 31)]; }
    LDS_WAIT(); asm volatile("" ::: "memory");
    const int c = lane & 7;
#pragma unroll
    for (int j = 0; j < 4; ++j) { const int n = (lane >> 3) + 8 * j; const LAS float* s = scr + (8 * c) * 33 + n;
        v4u o; o.x = pk2(s[0 * 33], s[1 * 33]); o.y = pk2(s[2 * 33], s[3 * 33]); o.z = pk2(s[4 * 33], s[5 * 33]); o.w = pk2(s[6 * 33], s[7 * 33]);
        *(v4u*)(WT + (size_t)(row_off + n0 + n) * K + k0 + 8 * c) = o; }
    LDS_WAIT(); asm volatile("" ::: "memory");
}
__device__ __forceinline__ void rms_row_to_bf16(const float* xrow, const float* gain, bf16* orow, int lane) {
    const f32x4* xr = (const f32x4*)xrow + lane; const f32x4* gr = (const f32x4*)gain + lane;
    f32x4 v[4]; float s = 0.f;
#pragma unroll
    for (int j = 0; j < 4; ++j) { v[j] = xr[64 * j]; s += (v[j].x * v[j].x + v[j].y * v[j].y) + (v[j].z * v[j].z + v[j].w * v[j].w); }
    const float rstd = 1.f / sqrtf(wave_sum(s) * (1.f / DMODEL) + 1e-6f);
    v2u* o8 = (v2u*)orow + lane;
#pragma unroll
    for (int j = 0; j < 4; ++j) { const f32x4 g = gr[64 * j]; v2u w; w.x = pk2(v[j].x * rstd * g.x, v[j].y * rstd * g.y); w.y = pk2(v[j].z * rstd * g.z, v[j].w * rstd * g.w); o8[64 * j] = w; }
}
template <bool NEXT> __device__ __forceinline__ void post_row(const float* orow, const float* xin, const float* gpost, float* xout, const float* gpre, bf16* xn, int lane) {
    const f32x4* pr = (const f32x4*)orow + lane; const f32x4* xr = (const f32x4*)xin + lane; const f32x4* gr = (const f32x4*)gpost + lane;
    f32x4 v[4]; float s = 0.f;
#pragma unroll
    for (int j = 0; j < 4; ++j) { v[j] = pr[64 * j]; s += (v[j].x * v[j].x + v[j].y * v[j].y) + (v[j].z * v[j].z + v[j].w * v[j].w); }
    const float rstd = 1.f / sqrtf(wave_sum(s) * (1.f / DMODEL) + 1e-6f); float s2 = 0.f;
#pragma unroll
    for (int j = 0; j < 4; ++j) { v[j] = xr[64 * j] + v[j] * rstd * gr[64 * j]; ((f32x4*)xout + lane)[64 * j] = v[j]; s2 += (v[j].x * v[j].x + v[j].y * v[j].y) + (v[j].z * v[j].z + v[j].w * v[j].w); }
    if (NEXT) { const float r2 = 1.f / sqrtf(wave_sum(s2) * (1.f / DMODEL) + 1e-6f); const f32x4* g2 = (const f32x4*)gpre + lane; v2u* o8 = (v2u*)xn + lane;
#pragma unroll
        for (int j = 0; j < 4; ++j) { const f32x4 g = g2[64 * j]; v2u w; w.x = pk2(v[j].x * r2 * g.x, v[j].y * r2 * g.y); w.y = pk2(v[j].z * r2 * g.z, v[j].w * r2 * g.w); o8[64 * j] = w; } }
}
__device__ __forceinline__ void combine_row(const bf16* O, const bf16* G, const float* subln, bf16* Y, int row, float lam, int lane) {
    const int h = lane >> 3, j = lane & 7;
    const v4u* p0 = (const v4u*)(O + (size_t)row * 2048 + h * 256 + j * 16); const v4u* p1 = (const v4u*)(O + (size_t)row * 2048 + h * 256 + 128 + j * 16);
    const v4u a0 = p0[0], a1 = p0[1], b0 = p1[0], b1 = p1[1];
    float d[16];
#pragma unroll
    for (int k = 0; k < 4; ++k) { d[2 * k] = bflo(a0[k]) - lam * bflo(b0[k]); d[2 * k + 1] = bfhi(a0[k]) - lam * bfhi(b0[k]); d[8 + 2 * k] = bflo(a1[k]) - lam * bflo(b1[k]); d[8 + 2 * k + 1] = bfhi(a1[k]) - lam * bfhi(b1[k]); }
    float ss = 0.f;
#pragma unroll
    for (int k = 0; k < 16; ++k) ss += d[k] * d[k];
    ss += pg8::swz_xor<1>(ss); ss += pg8::swz_xor<2>(ss); ss += pg8::swz_xor<4>(ss);
    const float rstd = 0.8f / sqrtf(ss * (1.f / 128.f) + 1e-5f);
    const v4u* gp = (const v4u*)(G + (size_t)row * 2048 + 1024 + h * 128 + j * 16); const v4u g0 = gp[0], g1 = gp[1];
    const f32x4* sp = (const f32x4*)(subln + j * 16); const f32x4 s0 = sp[0], s1 = sp[1], s2 = sp[2], s3 = sp[3];
    const float sl[16] = {s0.x, s0.y, s0.z, s0.w, s1.x, s1.y, s1.z, s1.w, s2.x, s2.y, s2.z, s2.w, s3.x, s3.y, s3.z, s3.w};
    v4u o0, o1;
#pragma unroll
    for (int k = 0; k < 4; ++k) { o0[k] = pk2(d[2 * k] * rstd * sl[2 * k] * bflo(g0[k]), d[2 * k + 1] * rstd * sl[2 * k + 1] * bfhi(g0[k]));
        o1[k] = pk2(d[8 + 2 * k] * rstd * sl[8 + 2 * k] * bflo(g1[k]), d[8 + 2 * k + 1] * rstd * sl[8 + 2 * k + 1] * bfhi(g1[k])); }
    v4u* yp = (v4u*)(Y + (size_t)row * 2048 + 1024 + h * 128 + j * 16); yp[0] = o0; yp[1] = o1;
}
#ifdef PROBE_NOSKIP
#define SGU_TB0(ks) 0
#else
#define SGU_TB0(ks) (2 * (ks))
#endif
#ifndef ATT_THRL
#define ATT_THRL 8
#endif
constexpr int SG_W = 0, SG_VT = 34816, SG_ST = 34816 + 69632, SG_STRIDE = 272, SG_MSTRIDE = 528;
__device__ __forceinline__ void sgu_unit(const Frame& F, int ch, int g, bf16* U, const bf16* V, const bf16* G, const float* stats, const bf16* Wm, const float* lng, const float* lnb, const float* sgub) {
    LAS unsigned char* lds = F.lds; const int tid = F.tid, lane = F.lane, wave = F.wave; const int row0 = ch * 128;
    LAS float* ST = (LAS float*)(lds + SG_ST);
    if (tid < 128) { const f32x4* p = (const f32x4*)(stats + (size_t)(row0 + tid) * 64); float s = 0.f, q = 0.f;
#ifdef PROBE_STATS
        for (int k = 0; k < 256; ++k) { const v4u r = *(const v4u*)(V + (size_t)(row0 + tid) * 2048 + k * 8);
#pragma unroll
            for (int e = 0; e < 4; ++e) { const float lo = bflo(r[e]), hi = bfhi(r[e]); s += lo + hi; q += lo * lo + hi * hi; } }
#else
#pragma unroll
        for (int k = 0; k < 16; ++k) { const f32x4 t = p[k]; s += t.x + t.z; q += t.y + t.w; }
#endif
        const float mu = s * (1.f / 2048.f), var = q * (1.f / 2048.f) - mu * mu; ST[2 * tid] = mu; ST[2 * tid + 1] = 1.f / sqrtf(var + 1e-6f); }
#pragma unroll
    for (int i = 0; i < 4; ++i) { const int c = tid + 512 * i, t = c >> 4, k8 = c & 15; const v4u w = *(const v4u*)(Wm + (size_t)(g * 128 + t) * 128 + k8 * 8); *(LAS v4u*)(lds + SG_W + t * SG_STRIDE + k8 * 16) = w; }
    __syncthreads();
    { const int db = tid & 31, sb = tid >> 5, d0 = db * 8, s0 = sb * 8;
      const f32x4 ga = *(const f32x4*)(lng + g * 256 + d0), gb = *(const f32x4*)(lng + g * 256 + d0 + 4), ba = *(const f32x4*)(lnb + g * 256 + d0), bb = *(const f32x4*)(lnb + g * 256 + d0 + 4);
      const float gl[8] = {ga.x, ga.y, ga.z, ga.w, gb.x, gb.y, gb.z, gb.w}, bl[8] = {ba.x, ba.y, ba.z, ba.w, bb.x, bb.y, bb.z, bb.w};
      float f[8][8];
#pragma unroll
      for (int i = 0; i < 8; ++i) { const v4u raw = *(const v4u*)(V + (size_t)(row0 + s0 + i) * 2048 + g * 256 + d0); const float mu = ST[2 * (s0 + i)], rs = ST[2 * (s0 + i) + 1];
#pragma unroll
          for (int k = 0; k < 4; ++k) { f[i][2 * k] = (bflo(raw[k]) - mu) * rs * gl[2 * k] + bl[2 * k]; f[i][2 * k + 1] = (bfhi(raw[k]) - mu) * rs * gl[2 * k + 1] + bl[2 * k + 1]; } }
#pragma unroll
      for (int dd = 0; dd < 8; ++dd) { v4u w; w.x = pk2(f[0][dd], f[1][dd]); w.y = pk2(f[2][dd], f[3][dd]); w.z = pk2(f[4][dd], f[5][dd]); w.w = pk2(f[6][dd], f[7][dd]);
          *(LAS v4u*)(lds + SG_VT + (d0 + dd) * SG_STRIDE + s0 * 2) = w; } }
    __syncthreads();
    f32x4 acc[2][8];
#pragma unroll
    for (int a = 0; a < 2; ++a)
#pragma unroll
        for (int b = 0; b < 8; ++b) acc[a][b] = (f32x4){0.f, 0.f, 0.f, 0.f};
    const int fr = lane & 15, fq = lane >> 4;
#pragma unroll
    for (int ks = 0; ks < 4; ++ks) { bf16x8 af[2];
#pragma unroll
        for (int a = 0; a < 2; ++a) af[a] = *(const LAS bf16x8*)(lds + SG_VT + (32 * wave + 16 * a + fr) * SG_STRIDE + (32 * ks + 8 * fq) * 2);
#pragma unroll
        for (int tb = SGU_TB0(ks); tb < 8; ++tb) { const bf16x8 bfr = *(const LAS bf16x8*)(lds + SG_W + (16 * tb + fr) * SG_STRIDE + (32 * ks + 8 * fq) * 2);
#pragma unroll
            for (int a = 0; a < 2; ++a) acc[a][tb] = __builtin_amdgcn_mfma_f32_16x16x32_bf16(af[a], bfr, acc[a][tb], 0, 0, 0); } }
    __syncthreads();
#pragma unroll
    for (int a = 0; a < 2; ++a)
#pragma unroll
        for (int tb = 0; tb < 8; ++tb) { v2u w; w.x = pk2(acc[a][tb][0], acc[a][tb][1]); w.y = pk2(acc[a][tb][2], acc[a][tb][3]);
            *(LAS v2u*)(lds + SG_VT + (16 * tb + fr) * SG_MSTRIDE + (32 * wave + 16 * a + 4 * fq) * 2) = w; }
    __syncthreads();
#pragma unroll
    for (int i = 0; i < 8; ++i) { const int c = tid + 512 * i, t = c >> 5, d8 = c & 31; const size_t off = (size_t)(row0 + t) * 2048 + g * 256 + d8 * 8;
        const v4u uu = *(const v4u*)(U + off), gg = *(const v4u*)(G + off), mm = *(const LAS v4u*)(lds + SG_VT + t * SG_MSTRIDE + d8 * 16); const float bs = sgub[g * 128 + t];
        v4u o;
#pragma unroll
        for (int k = 0; k < 4; ++k) o[k] = pk2(bflo(uu[k]) * (bflo(mm[k]) + bs) * bflo(gg[k]), bfhi(uu[k]) * (bfhi(mm[k]) + bs) * bfhi(gg[k]));
        *(v4u*)(U + off) = o; }
    __syncthreads();
}


#ifdef CHECK
#ifndef CHK_TOL
#define CHK_TOL 0.06f
#endif
constexpr size_t WS_CHK = 250 * MiB;
__device__ __forceinline__ unsigned hsh(unsigned x) { x ^= x >> 16; x *= 0x7feb352du; x ^= x >> 15; x *= 0x846ca68bu; x ^= x >> 16; return x; }
__device__ __forceinline__ float bfv(const bf16* p) { return __uint_as_float((unsigned)(*p) << 16); }
__device__ __forceinline__ float wdot(const bf16* a, const bf16* b, int n, int lane) { float s = 0.f;
    for (int k = lane * 8; k < n; k += 512) { const v4u x = *(const v4u*)(a + k), y = *(const v4u*)(b + k);
#pragma unroll
        for (int e = 0; e < 4; ++e) s += bflo(x[e]) * bflo(y[e]) + bfhi(x[e]) * bfhi(y[e]); }
    return wave_sum(s); }
__device__ __forceinline__ float wave_max(float v) { v = fmaxf(v, pg8::swz_xor<1>(v)); v = fmaxf(v, pg8::swz_xor<2>(v)); v = fmaxf(v, pg8::swz_xor<4>(v)); v = fmaxf(v, pg8::swz_xor<8>(v)); v = fmaxf(v, pg8::swz_xor<16>(v));
    auto rr = __builtin_amdgcn_permlane32_swap(__float_as_uint(v), __float_as_uint(v), false, false); return fmaxf(__uint_as_float(rr[0]), __uint_as_float(rr[1])); }
__device__ __forceinline__ void chk_put(unsigned* chk, int k, float got, float want, float tol_abs) { float e = fabsf(got - want) / (fabsf(want) + tol_abs); if (!(e == e)) e = 1e9f; e = wave_max(e); atomicMax(chk + k, __float_as_uint(e)); }
#define CHKPTR ((unsigned*)((unsigned char*)ldp(PT, 18) + WS_CHK))
#endif
struct Args { const float* in[17]; const int* pos; float* out; unsigned char* ws; };
__global__ void __launch_bounds__(NWAVES * 64, 2) fwd_megakernel(Args args) {
    extern __shared__ __attribute__((aligned(16))) unsigned char lds[];
    cg::grid_group grid = cg::this_grid();
    Frame F; F.lds = (LAS unsigned char*)lds; F.tid = threadIdx.x; F.lane = F.tid & 63; F.wave = __builtin_amdgcn_readfirstlane(F.tid >> 6);
    F.G = gridDim.x; { const int bx = blockIdx.x; F.vcu = (F.G % 8 == 0) ? (bx % 8) * (F.G / 8) + bx / 8 : bx; }
    LAS unsigned long long* PT = (LAS unsigned long long*)(F.lds + 131072 + 1024);
    if (F.tid == 0) {
#define PTSET(k) PT[k] = (unsigned long long)args.in[k]
        PTSET(0); PTSET(1); PTSET(2); PTSET(3); PTSET(4); PTSET(5); PTSET(6); PTSET(7); PTSET(8); PTSET(9); PTSET(10); PTSET(11); PTSET(12); PTSET(13); PTSET(14); PTSET(15); PTSET(16);
#undef PTSET
        PT[17] = (unsigned long long)args.out; PT[18] = (unsigned long long)args.ws; }
    __syncthreads();
#define GRID_SYNC() do { asm volatile("s_waitcnt vmcnt(0) lgkmcnt(0)" ::: "memory"); grid.sync(); asm volatile("buffer_inv sc1\n\ts_waitcnt vmcnt(0)" ::: "memory"); } while (0)
#define REFRESH() do { int t_ = threadIdx.x; asm volatile("" : "+v"(t_)); F.tid = t_; F.lane = t_ & 63; } while (0)
#define PIN(k) ((const float*)ldp(PT, k))
#define POUT ((float*)ldp(PT, 17))
#define WSB(off) ((bf16*)((unsigned char*)ldp(PT, 18) + (off)))
#define WSF(off) ((float*)((unsigned char*)ldp(PT, 18) + (off)))
    const int gw = F.vcu * NWAVES + F.wave, NGW = F.G * NWAVES;
    LAS float* scr = (LAS float*)(F.lds + F.wave * 16384);

#ifndef SKIP_P0
    {
        REFRESH();
        const float *x = PIN(0), *pre_norm = PIN(2), *w_in = PIN(4), *w_out = PIN(5), *pool_w = PIN(6); const int* pos = (const int*)PIN(1); bf16 *Win_t = WSB(WS_WIN), *Wout_t = WSB(WS_WOUT), *Poolw_t = WSB(WS_POOLW), *XN = WSB(WS_XN); float* rope = WSF(WS_ROPE);
        constexpr int I_IN = (DMODEL / 64) * (INCOLS / 32), I_OUT = (DIN / 64) * (DMODEL / 32), I_PW = (256 / 64) * (256 / 32);
        for (int it = gw; it < I_IN + I_OUT + 4 * I_PW; it += NGW) { int r = it;
            if (r < I_IN) { p0_transpose_item(w_in, DMODEL, INCOLS, Win_t, 0, scr, r, F.lane); continue; } r -= I_IN;
            if (r < I_OUT) { p0_transpose_item(w_out, DIN, DMODEL, Wout_t, 0, scr, r, F.lane); continue; } r -= I_OUT;
            const int gq = r / I_PW; p0_transpose_item(pool_w + (size_t)gq * 65536, 256, 256, Poolw_t, gq * 256, scr, r % I_PW, F.lane); }
        for (int i = blockIdx.x * 512 + F.tid; i < M * 8; i += F.G * 512) { const int row = i >> 3, k = i & 7;
            const float inv = __powf(500000.0f, -(float)k * 0.125f); const float ang = (float)pos[row] * inv; float sn, cs; sincosf(ang, &sn, &cs);
            rope[(size_t)row * 16 + k] = cs; rope[(size_t)row * 16 + 8 + k] = sn; }
        for (int m = gw; m < M; m += NGW) rms_row_to_bf16(x + (size_t)m * DMODEL, pre_norm, XN + (size_t)m * DMODEL, F.lane);
#ifdef CHECK
        if (blockIdx.x == 0 && F.tid < 16) CHKPTR[F.tid] = (F.tid == 12) ? 0xffffu : 0u;
#endif
    }
#endif
    GRID_SYNC();
#ifndef SKIP_P1
    {
        bf16 *XN = WSB(WS_XN), *Win_t = WSB(WS_WIN), *Abuf = WSB(WS_A), *G0 = (bf16*)POUT; float* rope = WSF(WS_ROPE);
        pg8::Gemm g{XN, Win_t, M, INCOLS, DMODEL, DMODEL, DMODEL, 0}; pg8::StaticOrder S; S.init(M, INCOLS, F.G, (int)blockIdx.x);
        pg8::EpiProj0 E{Abuf, G0, (size_t)(WS_Q - WS_A) / 2, rope, attn_body::C2};
        pg8::gemm_phase<pg8::EpiProj0, pg8::StaticOrder, PG_ALIGN, PG_SP2>(F.lds, g, S, E);
    }
#endif
    GRID_SYNC();
#ifdef CHECK
    { REFRESH(); unsigned* chk = CHKPTR; bf16 *XN = WSB(WS_XN), *Win_t = WSB(WS_WIN), *Abuf = WSB(WS_A), *G0 = (bf16*)POUT; const float* rope = WSF(WS_ROPE);
      for (int i = gw; i < 4096; i += NGW) { const int row = hsh(i * 2 + 1) % M, c = (i < 64) ? (1024 + (i & 15) + 64 * (i >> 4)) : hsh(i * 2 + 2) % INCOLS; const int reg = c >> 10;
          const float p = wdot(XN + (size_t)row * 1024, Win_t + (size_t)c * 1024, 1024, F.lane); float want = p;
          if (reg == 1 || reg == 2) { const int d = c & 63; if (d < 16) { const int pc = d < 8 ? c + 8 : c - 8; const float p2 = wdot(XN + (size_t)row * 1024, Win_t + (size_t)pc * 1024, 1024, F.lane);
                  const float cs = rope[(size_t)row * 16 + (d & 7)], sn = rope[(size_t)row * 16 + 8 + (d & 7)]; want = d < 8 ? p * cs - p2 * sn : p * cs + p2 * sn; } if (reg == 1) want *= attn_body::C2; }
          if (reg >= 4) want = pg8::silu_f(p);
          const float got = reg < 4 ? bfv(Abuf + (size_t)reg * ((WS_Q - WS_A) / 2) + (size_t)row * 1024 + (c & 1023)) : bfv(G0 + (size_t)row * 2048 + (c - 4096));
          chk_put(chk, 0, got, want, 0.05f); } }
    GRID_SYNC();
#endif
#ifdef PROBE_ROPE
    { REFRESH(); bf16 *Qb = WSB(WS_Q), *Kb = WSB(WS_K); const float* rope = WSF(WS_ROPE);
      for (int idx = blockIdx.x * 512 + F.tid; idx < M * 32; idx += F.G * 512) { const int row = idx >> 5, hc = idx & 31; bf16* p = (hc < 16 ? Qb : Kb) + (size_t)row * 1024 + (hc & 15) * 64;
          v4u a = *(v4u*)p, b = *(v4u*)(p + 8); const float* rp = rope + (size_t)row * 16; float x1[8], x2[8];
#pragma unroll
          for (int k = 0; k < 4; ++k) { x1[2 * k] = bflo(a[k]); x1[2 * k + 1] = bfhi(a[k]); x2[2 * k] = bflo(b[k]); x2[2 * k + 1] = bfhi(b[k]); }
#pragma unroll
          for (int k = 0; k < 4; ++k) { const float c0 = rp[2 * k], s0 = rp[8 + 2 * k], c1 = rp[2 * k + 1], s1 = rp[8 + 2 * k + 1];
              a[k] = pk2(x1[2 * k] * c0 - x2[2 * k] * s0, x1[2 * k + 1] * c1 - x2[2 * k + 1] * s1); b[k] = pk2(x2[2 * k] * c0 + x1[2 * k] * s0, x2[2 * k + 1] * c1 + x1[2 * k + 1] * s1); }
          *(v4u*)p = a; *(v4u*)(p + 8) = b; } }
    GRID_SYNC();
#endif
#ifndef SKIP_P2
    {
        bf16 *Qb = WSB(WS_Q), *Kb = WSB(WS_K), *Vb = WSB(WS_V), *Ob = WSB(WS_O);
        const attn_body::AttnTensors AT{(const attn_body::bf16*)Qb, (const attn_body::bf16*)Kb, (const attn_body::bf16*)Vb, (attn_body::bf16*)Ob};
        const attn_body::StaticOrder S((int)F.G, (int)blockIdx.x);
        attn_body::attn_phase<attn_body::StaticOrder, ATT_THRL>((char*)lds, AT, S);
    }
#endif
    GRID_SYNC();
#ifdef CHECK
    { REFRESH(); unsigned* chk = CHKPTR; bf16 *Qb = WSB(WS_Q), *Kb = WSB(WS_K), *Vb = WSB(WS_V), *Ob = WSB(WS_O);
      for (int i = gw; i < 2048; i += NGW) { const unsigned hh = hsh(i * 3 + 7); const int b = hh & 3, vh = (hh >> 2) & 31; int row = (i < 256) ? i : (int)(hsh(i * 3 + 8) % SEQ); if (i >= 256 && i < 512) row = SEQ - 1 - (i - 256);
          const int qcol = (vh >> 2) * 128 + ((vh >> 1) & 1) * 64, vcol = (vh >> 2) * 128 + (vh & 1) * 64; const size_t rb = (size_t)b * SEQ;
          const bf16* qp = Qb + (rb + row) * 1024 + qcol; float m = -INFINITY;
          for (int k0 = 0; k0 <= row; k0 += 64) { const int k = k0 + F.lane; float s = -INFINITY; if (k <= row) { s = 0.f; const bf16* kp = Kb + (rb + k) * 1024 + qcol; for (int d = 0; d < 64; ++d) s += bfv(qp + d) * bfv(kp + d); } m = fmaxf(m, s); }
          m = wave_max(m); float l = 0.f, o = 0.f;
          for (int k0 = 0; k0 <= row; k0 += 64) { const int k = k0 + F.lane; float p = 0.f; if (k <= row) { float s = 0.f; const bf16* kp = Kb + (rb + k) * 1024 + qcol; for (int d = 0; d < 64; ++d) s += bfv(qp + d) * bfv(kp + d); p = __builtin_amdgcn_exp2f(s - m); }
              l += p; const int nk = (row - k0 + 1 < 64) ? row - k0 + 1 : 64; for (int j = 0; j < nk; ++j) { const float pj = __shfl(p, j); o += pj * bfv(Vb + (rb + k0 + j) * 1024 + vcol + F.lane); } }
          l = wave_sum(l); const float want = o / l, got = bfv(Ob + (rb + row) * 2048 + vh * 64 + F.lane);
          chk_put(chk, 1, got, want, 0.15f); } }
    GRID_SYNC();
#endif
#ifndef SKIP_P2b
    {
        REFRESH();
        const float *lq1 = PIN(8), *lk1 = PIN(9), *lq2 = PIN(10), *lk2 = PIN(11), *subln = PIN(12); bf16 *Abuf = WSB(WS_A), *XN = WSB(WS_XN), *Ob = WSB(WS_O), *Yb = WSB(WS_Y), *G0 = (bf16*)POUT;
        for (int task = blockIdx.x * 512 + F.tid; task < M * 128; task += F.G * 512) { const int row = task >> 7, ck = task & 127, gq = ck >> 5, w = 2 << gq, s = row & (SEQ - 1), cnt = (s + 1 < w) ? s + 1 : w;
            float sum[8], a0[8];
#pragma unroll
            for (int k = 0; k < 8; ++k) sum[k] = 0.f;
            for (int j = 0; j < cnt; ++j) { const v4u r = *(const v4u*)(Abuf + (size_t)(row - j) * 1024 + ck * 8);
#pragma unroll
                for (int k = 0; k < 4; ++k) { const float lo = bflo(r[k]), hi = bfhi(r[k]); sum[2 * k] += lo; sum[2 * k + 1] += hi; if (j == 0) { a0[2 * k] = lo; a0[2 * k + 1] = hi; } } }
            const float rc = 1.f / (float)cnt; v4u o;
#pragma unroll
            for (int k = 0; k < 4; ++k) o[k] = pk2(sum[2 * k] * rc - a0[2 * k], sum[2 * k + 1] * rc - a0[2 * k + 1]);
            *(v4u*)(XN + (size_t)row * 1024 + ck * 8) = o; }
        float lam; { const float a = wave_sum(lq1[F.lane] * lk1[F.lane]), b = wave_sum(lq2[F.lane] * lk2[F.lane]); lam = expf(a) - expf(b) + 0.2f; }
        for (int m = gw; m < M; m += NGW) combine_row(Ob, G0, subln, Yb, m, lam, F.lane);
    }
#endif
    GRID_SYNC();
#ifndef SKIP_P2c
    {
        const float* pool_scale = PIN(7); bf16 *XN = WSB(WS_XN), *Poolw_t = WSB(WS_POOLW), *Yb = WSB(WS_Y), *G0 = (bf16*)POUT;
        pg8::Gemm g{XN, Poolw_t, M, 1024, 256, 1024, 256, 512}; pg8::StaticOrder S; S.init(M, 1024, F.G, (int)blockIdx.x);
        pg8::EpiPool E{Yb, G0, pool_scale};
        pg8::gemm_phase<pg8::EpiPool, pg8::StaticOrder, PG_ALIGN, PG_SP2>(F.lds, g, S, E);
    }
#endif
    GRID_SYNC();
#ifdef CHECK
    { REFRESH(); unsigned* chk = CHKPTR; const float *lq1 = PIN(8), *lk1 = PIN(9), *lq2 = PIN(10), *lk2 = PIN(11), *subln = PIN(12), *pool_scale = PIN(7); bf16 *Abuf = WSB(WS_A), *XN = WSB(WS_XN), *Ob = WSB(WS_O), *Yb = WSB(WS_Y), *G0 = (bf16*)POUT, *Poolw_t = WSB(WS_POOLW);
      float lam; { const float a = wave_sum(lq1[F.lane] * lk1[F.lane]), b = wave_sum(lq2[F.lane] * lk2[F.lane]); lam = expf(a) - expf(b) + 0.2f; }
      for (int i = gw; i < 4096; i += NGW) { const int row = (i < 512) ? ((i & 127) + (i >> 7) * SEQ) : (int)(hsh(i * 5 + 1) % M); const int col = (hsh(i * 5 + 2) % 16) * 64 + F.lane, g = col >> 8, w = 2 << g, s = row & (SEQ - 1), cnt = (s + 1 < w) ? s + 1 : w;
          float sum = 0.f; for (int j = 0; j < cnt; ++j) sum += bfv(Abuf + (size_t)(row - j) * 1024 + col); const float want = sum / (float)cnt - bfv(Abuf + (size_t)row * 1024 + col);
          chk_put(chk, 2, bfv(XN + (size_t)row * 1024 + col), want, 0.05f);
          const int h = hsh(i * 5 + 3) & 7; float o0 = bfv(Ob + (size_t)row * 2048 + h * 256 + F.lane) - lam * bfv(Ob + (size_t)row * 2048 + h * 256 + 128 + F.lane), o1 = bfv(Ob + (size_t)row * 2048 + h * 256 + 64 + F.lane) - lam * bfv(Ob + (size_t)row * 2048 + h * 256 + 192 + F.lane);
          const float ss = wave_sum(o0 * o0 + o1 * o1), rs = 0.8f / sqrtf(ss / 128.f + 1e-5f);
          chk_put(chk, 3, bfv(Yb + (size_t)row * 2048 + 1024 + h * 128 + F.lane), o0 * rs * subln[F.lane] * bfv(G0 + (size_t)row * 2048 + 1024 + h * 128 + F.lane), 0.03f);
          chk_put(chk, 3, bfv(Yb + (size_t)row * 2048 + 1024 + h * 128 + 64 + F.lane), o1 * rs * subln[64 + F.lane] * bfv(G0 + (size_t)row * 2048 + 1024 + h * 128 + 64 + F.lane), 0.03f);
          const int c2 = hsh(i * 5 + 4) % 1024, g2 = c2 >> 8; const float yp = wdot(XN + (size_t)row * 1024 + g2 * 256, Poolw_t + (size_t)c2 * 256, 256, F.lane) * pool_scale[c2] * bfv(G0 + (size_t)row * 2048 + c2);
          chk_put(chk, 4, bfv(Yb + (size_t)row * 2048 + c2), yp, 0.05f); } }
    GRID_SYNC();
#endif
#ifndef SKIP_P3
    {
        bf16 *Yb = WSB(WS_Y), *Wout_t = WSB(WS_WOUT); float* out0 = WSF(WS_OUT0);
        pg8::Gemm g{Yb, Wout_t, M, DMODEL, DIN, DIN, DIN, 0}; pg8::StaticOrder S; S.init(M, DMODEL, F.G, (int)blockIdx.x);
        pg8::EpiF32 E{out0, DMODEL};
        pg8::gemm_phase<pg8::EpiF32, pg8::StaticOrder, PG_ALIGN, PG_SP2>(F.lds, g, S, E);
    }
#endif
    GRID_SYNC();
#ifdef CHECK
    { REFRESH(); unsigned* chk = CHKPTR; bf16 *Yb = WSB(WS_Y), *Wout_t = WSB(WS_WOUT); float* out0 = WSF(WS_OUT0);
      for (int i = gw; i < 4096; i += NGW) { const int row = hsh(i * 7 + 1) % M, col = hsh(i * 7 + 2) % 1024;
          chk_put(chk, 5, out0[(size_t)row * 1024 + col], wdot(Yb + (size_t)row * 2048, Wout_t + (size_t)col * 2048, 2048, F.lane), 0.05f); } }
    GRID_SYNC();
#endif
#ifndef SKIP_P3b
    {
        REFRESH();
        const float *x = PIN(0), *pre_norm = PIN(2), *post_norm = PIN(3), *w_in = PIN(4), *w_out = PIN(5), *sgu_w = PIN(15); float *out = POUT, *out0 = WSF(WS_OUT0); bf16 *Win_t = WSB(WS_WIN), *Wout_t = WSB(WS_WOUT), *Poolw_t = WSB(WS_POOLW), *Abuf = WSB(WS_A);
        constexpr int I_IN = (DMODEL / 64) * (INCOLS / 32), I_OUT = (DIN / 64) * (DMODEL / 32);
        for (int it = gw; it < I_IN + I_OUT; it += NGW) { int r = it;
            if (r < I_IN) { p0_transpose_item(w_in + (size_t)DMODEL * INCOLS, DMODEL, INCOLS, Win_t, 0, scr, r, F.lane); continue; } r -= I_IN;
            p0_transpose_item(w_out + (size_t)DIN * DMODEL, DIN, DMODEL, Wout_t, 0, scr, r, F.lane); }
        for (int i = blockIdx.x * 512 + F.tid; i < 8 * 128 * 128; i += F.G * 512) { const int s = i & 127, t = (i >> 7) & 127; Poolw_t[i] = (bf16)((s <= t) ? f2bf(sgu_w[i]) : 0u); }
        for (int m = gw; m < M; m += NGW) post_row<true>(out0 + (size_t)m * DMODEL, x + (size_t)m * DMODEL, post_norm, out + (size_t)m * DMODEL, pre_norm + DMODEL, Abuf + (size_t)m * DMODEL, F.lane);
    }
#endif
    GRID_SYNC();
#ifndef SKIP_P4
    {
        bf16 *Abuf = WSB(WS_A), *Win_t = WSB(WS_WIN), *Ub = WSB(WS_U); float* stats = WSF(WS_STATS);
        pg8::Gemm g{Abuf, Win_t, M, INCOLS, DMODEL, DMODEL, DMODEL, 0}; pg8::StaticOrder S; S.init(M, INCOLS, F.G, (int)blockIdx.x);
        pg8::EpiProj1 E{Ub, (size_t)(WS_V1 - WS_U) / 2, stats};
        pg8::gemm_phase<pg8::EpiProj1, pg8::StaticOrder, PG_ALIGN, PG_SP2>(F.lds, g, S, E);
    }
#endif
    GRID_SYNC();
#ifdef CHECK
    { REFRESH(); unsigned* chk = CHKPTR; bf16 *Abuf = WSB(WS_A), *Win_t = WSB(WS_WIN), *Ub = WSB(WS_U), *V1b = WSB(WS_V1); float* stats = WSF(WS_STATS);
      for (int i = gw; i < 4096; i += NGW) { const int row = hsh(i * 11 + 1) % M, c = hsh(i * 11 + 2) % INCOLS, reg = c >> 11;
          const float p = wdot(Abuf + (size_t)row * 1024, Win_t + (size_t)c * 1024, 1024, F.lane); const float want = reg < 2 ? pg8::gelu_tanh_f(p) : pg8::silu_f(p);
          chk_put(chk, 6, bfv(Ub + (size_t)reg * ((WS_V1 - WS_U) / 2) + (size_t)row * 2048 + (c & 2047)), want, 0.05f);
          float s = 0.f, q = 0.f; for (int k = F.lane; k < 2048; k += 64) { const float v = bfv(V1b + (size_t)row * 2048 + k); s += v; q += v * v; } s = wave_sum(s); q = wave_sum(q);
          float s2 = 0.f, q2 = 0.f; if (F.lane < 32) { s2 = stats[(size_t)row * 64 + 2 * F.lane]; q2 = stats[(size_t)row * 64 + 2 * F.lane + 1]; } s2 = wave_sum(s2); q2 = wave_sum(q2);
          chk_put(chk, 7, s + 50.f * (s2 - s), s, 1.0f); chk_put(chk, 7, q + 50.f * (q2 - q), q, 1.0f); } }
    GRID_SYNC();
#endif
#ifndef SKIP_P5
    { REFRESH(); const float *ln_g = PIN(13), *ln_b = PIN(14), *sgu_b = PIN(16); bf16 *Ub = WSB(WS_U), *V1b = WSB(WS_V1), *G1b = WSB(WS_G1), *Poolw_t = WSB(WS_POOLW); float* stats = WSF(WS_STATS);
    for (int un = F.vcu; un < 128 * 8; un += F.G) sgu_unit(F, un >> 3, un & 7, Ub, V1b, G1b, stats, Poolw_t, ln_g, ln_b, sgu_b); }
#endif
    GRID_SYNC();
#ifdef CHECK
    { REFRESH(); unsigned* chk = CHKPTR; const float *ln_g = PIN(13), *ln_b = PIN(14), *sgu_b = PIN(16); bf16 *Abuf = WSB(WS_A), *Win_t = WSB(WS_WIN), *Ub = WSB(WS_U), *V1b = WSB(WS_V1), *G1b = WSB(WS_G1), *Wm = WSB(WS_POOLW);
      for (int i = gw; i < 2048; i += NGW) { const int row = (i < 256) ? (i & 127) * 129 % M : (int)(hsh(i * 13 + 1) % M), ch = hsh(i * 13 + 2) % 2048, t = row & 127, r0 = row - t, g = ch >> 8; float mixed = 0.f;
          for (int s = 0; s <= t; ++s) { float a = 0.f, q = 0.f; for (int k = F.lane; k < 2048; k += 64) { const float v = bfv(V1b + (size_t)(r0 + s) * 2048 + k); a += v; q += v * v; } a = wave_sum(a); q = wave_sum(q);
              const float mu = a / 2048.f, var = q / 2048.f - mu * mu, rs = 1.f / sqrtf(var + 1e-6f); const float vn = (bfv(V1b + (size_t)(r0 + s) * 2048 + ch) - mu) * rs * ln_g[ch] + ln_b[ch];
              mixed += bfv(Wm + (size_t)(g * 128 + t) * 128 + s) * vn; }
          mixed += sgu_b[g * 128 + t]; const float u = pg8::gelu_tanh_f(wdot(Abuf + (size_t)row * 1024, Win_t + (size_t)ch * 1024, 1024, F.lane));
          { const float got = bfv(Ub + (size_t)row * 2048 + ch), want = u * mixed * bfv(G1b + (size_t)row * 2048 + ch); chk_put(chk, 8, got, want, 0.05f);
            if (fabsf(got - want) / (fabsf(want) + 0.05f) > CHK_TOL) { atomicMin(chk + 12, (unsigned)((t << 3) | g)); atomicAdd(chk + 13, 1u); } } } }
    GRID_SYNC();
#endif
#ifndef SKIP_P6
    {
        bf16 *Ub = WSB(WS_U), *Wout_t = WSB(WS_WOUT); float* out1 = WSF(WS_OUT1);
        pg8::Gemm g{Ub, Wout_t, M, DMODEL, DIN, DIN, DIN, 0}; pg8::StaticOrder S; S.init(M, DMODEL, F.G, (int)blockIdx.x);
        pg8::EpiF32 E{out1, DMODEL};
        pg8::gemm_phase<pg8::EpiF32, pg8::StaticOrder, PG_ALIGN, PG_SP2>(F.lds, g, S, E);
    }
#endif
    GRID_SYNC();
#ifdef CHECK
    { REFRESH(); unsigned* chk = CHKPTR; bf16 *Ub = WSB(WS_U), *Wout_t = WSB(WS_WOUT); float* out1 = WSF(WS_OUT1);
      for (int i = gw; i < 4096; i += NGW) { const int row = hsh(i * 17 + 1) % M, col = hsh(i * 17 + 2) % 1024;
          chk_put(chk, 9, out1[(size_t)row * 1024 + col], wdot(Ub + (size_t)row * 2048, Wout_t + (size_t)col * 2048, 2048, F.lane), 0.05f); } }
    GRID_SYNC();
#endif
#ifndef SKIP_P7
    { REFRESH(); const float* post_norm = PIN(3); float *out = POUT, *out1 = WSF(WS_OUT1);
    for (int m = gw; m < M; m += NGW) post_row<false>(out1 + (size_t)m * DMODEL, out + (size_t)m * DMODEL, post_norm + DMODEL, out + (size_t)m * DMODEL, nullptr, nullptr, F.lane); }
#endif
#ifdef CHECK
    GRID_SYNC();
    if (blockIdx.x == 0 && F.tid == 0) { int kmin = -1; for (int k = 9; k >= 0; --k) if (__uint_as_float(CHKPTR[k]) > CHK_TOL) kmin = k; if (kmin >= 0) POUT[0] = (float)(1u << (25 - kmin));
#ifdef CHK_SGU_CODE
        { const unsigned code = CHK_SGU_CODE ? CHKPTR[13] : CHKPTR[12]; if (code != 0xffffu) { const float A = (float)(1u << (10 + (code >> 6))); const int N = (code & 63) + 1; for (int n = 0; n < N; ++n) POUT[n] = A; } }
#endif
    }
#endif
}

extern "C" void kernel_launch(void* const* d_in, const int* in_sizes, int n_in, void* d_out, int out_size, void* d_ws, size_t ws_size, hipStream_t stream) {
    static int grid = 0;
    if (grid == 0) {
        if (n_in != 17 || in_sizes[0] != M * DMODEL || out_size != M * DMODEL || ws_size < WS_END) { fprintf(stderr, "kernel_launch: unexpected shapes (n_in %d, ws %zu)\n", n_in, ws_size); grid = -1; return; }
        int dev = 0, cus = 0, per_cu = 0;
        hipGetDevice(&dev); hipDeviceGetAttribute(&cus, hipDeviceAttributeMultiprocessorCount, dev);
        if (hipFuncSetAttribute((const void*)fwd_megakernel, hipFuncAttributeMaxDynamicSharedMemorySize, LDS_BYTES) != hipSuccess) { fprintf(stderr, "kernel_launch: hipFuncSetAttribute failed\n"); grid = -1; return; }
        if (hipOccupancyMaxActiveBlocksPerMultiprocessor(&per_cu, (const void*)fwd_megakernel, NWAVES * 64, LDS_BYTES) != hipSuccess || per_cu < 1) { fprintf(stderr, "kernel_launch: occupancy query says %d\n", per_cu); per_cu = 1; }
        (void)hipGetLastError();
        grid = cus * 1;
    }
    if (grid < 0) return;
    Args a{};
    for (int i = 0; i < 17; ++i) a.in[i] = (const float*)d_in[i];
    a.pos = (const int*)d_in[1]; a.out = (float*)d_out; a.ws = (unsigned char*)d_ws;
    void* kargs[] = {&a};
    hipError_t e = hipLaunchCooperativeKernel((const void*)fwd_megakernel, dim3(grid), dim3(NWAVES * 64), kargs, LDS_BYTES, stream);
    if (e != hipSuccess) fprintf(stderr, "cooperative launch failed: %s (grid %d)\n", hipGetErrorString(e), grid);
}
```

```cpp
#include <hip/hip_runtime.h>
#include <hip/hip_cooperative_groups.h>
#include <cstdio>
#include <cstdint>

namespace pg8 {
#define PG8_LAS __attribute__((address_space(3)))
typedef unsigned short bf16_t;
typedef short bf16x8 __attribute__((ext_vector_type(8)));
typedef float f32x4 __attribute__((ext_vector_type(4)));
typedef unsigned u32x4 __attribute__((ext_vector_type(4)));
constexpr int BM = 256, BK = 64, HALF = 128, HTB = HALF * BK * 2  , STAGE_BYTES = 8 * HTB, NXCD = 8, WGM = 8;

__host__ __device__ __forceinline__ int lds_byte(int r, int c) { const int st = (r >> 4) * 2 + (c >> 5), rr = r & 15, cc = c & 31, ob = rr * 64 + cc * 2; return st * 1024 + (ob ^ (((ob >> 9) & 1) << 5)); }
__host__ __device__ __forceinline__ void stage_rc(int b, int& R, int& C) { const int st = b / 1024, sb = b % 1024, swz = sb ^ (((sb >> 9) & 1) << 5); R = (st >> 1) * 16 + swz / 64; C = (st & 1) * 32 + (swz % 64) / 2; }
__host__ __device__ __forceinline__ int perm32(int rho) { const int n = rho >> 4, i = rho & 15; return 8 * (i >> 2) + 4 * n + (i & 3); }

struct Unit { int pm, pn; };
struct Gemm { const bf16_t* A; const bf16_t* Bt; int M, N, K, lda, ldb, a_pn_bytes; };

struct StaticOrder {
    int nM, nN, nwg, G, c;
    __host__ __device__ void init(int M, int N, int G_, int c_) { nM = M / BM; nN = N / BM; nwg = nM * nN; G = G_; c = c_; }
    __host__ __device__ bool next(int i, Unit& u) const {
        const long L = (long)i * G + c; if (L >= nwg) return false;
        int wgid = (int)L; { const int q = nwg / NXCD, r = nwg % NXCD, xcd = wgid % NXCD, off = wgid / NXCD; wgid = (xcd < r ? xcd * (q + 1) : r * (q + 1) + (xcd - r) * q) + off; }
        const int nig = WGM * nN, gid = wgid / nig, fm = gid * WGM, gsz = (nM - fm) < WGM ? (nM - fm) : WGM;
        u.pm = fm + ((wgid % nig) % gsz); u.pn = (wgid % nig) / gsz; return true;
    }
    __device__ __forceinline__ void a_ready(const Unit&) const {}
    __device__ __forceinline__ void done(const Unit&) const {}
};

typedef float f32x2c_t __attribute__((ext_vector_type(2))); typedef __bf16 bf16x2c_t __attribute__((ext_vector_type(2)));
__device__ __forceinline__ unsigned cvt_pk_bf16(float lo, float hi) { const f32x2c_t v = {lo, hi}; const bf16x2c_t b = __builtin_convertvector(v, bf16x2c_t); return __builtin_bit_cast(unsigned, b); }
__device__ __forceinline__ float silu_f(float x) { return x * __builtin_amdgcn_rcpf(1.0f + __builtin_amdgcn_exp2f(-1.4426950408889634f * x)); }
__device__ __forceinline__ float gelu_tanh_f(float x) { const float z = 0.7978845608028654f * (x + 0.044715f * x * x * x); return x * __builtin_amdgcn_rcpf(1.0f + __builtin_amdgcn_exp2f(-2.8853900817779268f * z)); }
__device__ __forceinline__ u32x4 pack8(const f32x4& v0, const f32x4& v1) { u32x4 w; w.x = cvt_pk_bf16(v0[0], v0[1]); w.y = cvt_pk_bf16(v0[2], v0[3]); w.z = cvt_pk_bf16(v1[0], v1[1]); w.w = cvt_pk_bf16(v1[2], v1[3]); return w; }
template <int X> __device__ __forceinline__ float swz_xor(float v) { return __int_as_float(__builtin_amdgcn_ds_swizzle(__float_as_int(v), (X << 10) | 0x1F)); }
__device__ __forceinline__ float half_sum(float v) { auto rr = __builtin_amdgcn_permlane32_swap(__float_as_uint(v), __float_as_uint(v), false, false); return __uint_as_float(rr[0]) + __uint_as_float(rr[1]); }
__device__ __forceinline__ f32x4 shx16(const f32x4& v) { f32x4 r; r[0] = swz_xor<16>(v[0]); r[1] = swz_xor<16>(v[1]); r[2] = swz_xor<16>(v[2]); r[3] = swz_xor<16>(v[3]); return r; }

struct EpiProj0 {
    static constexpr bool PERM = true, AFTER_DRAIN = false;
    bf16_t *A, *G; size_t rstride; const float* rope; float qscale;
    __device__ __forceinline__ void operator()(const f32x4 (&acc)[2][2][4][2], const Unit& u, int wr, int wc, int fr, int fq) const {
        const int row0 = u.pm * BM + wr * 64 + fr, pn = u.pn, reg = pn >> 2;
        bf16_t* base; int ldc, colt;
        if (reg < 4) { base = A + (size_t)reg * rstride; ldc = 1024; colt = (pn & 3) * 256; } else { base = G; ldc = 2048; colt = (pn - 16) * 256; }
        const int col0 = colt + wc * 32 + 8 * fq;

#ifdef PROBE_ROPE
        const bool rot_tile = false,
#else
        const bool rot_tile = (reg == 1 || reg == 2),
#endif
        rot_lane = ((wc & 1) == 0) && (fq < 2), gate = reg >= 4;
        const float sc = (reg == 1) ? qscale : 1.f, sgn = (fq == 0) ? -1.f : 1.f;
#pragma unroll
        for (int ai = 0; ai < 2; ++ai)
#pragma unroll
            for (int m = 0; m < 4; ++m) { const int row = row0 + ai * HALF + m * 16; bf16_t* rowp = base + (size_t)row * ldc + col0;
                f32x4 c0 = {1.f, 1.f, 1.f, 1.f}, c1 = c0, s0 = {0.f, 0.f, 0.f, 0.f}, s1 = s0;
                if (rot_tile) { const f32x4* rp = (const f32x4*)(rope + (size_t)row * 16); c0 = rp[0]; c1 = rp[1]; s0 = rp[2]; s1 = rp[3]; }
#pragma unroll
                for (int bj = 0; bj < 2; ++bj) { f32x4 v0 = acc[ai][bj][m][0], v1 = acc[ai][bj][m][1];
                    if (rot_tile) { const f32x4 p0 = shx16(v0), p1 = shx16(v1); const f32x4 r0 = v0 * c0 + (p0 * s0) * sgn, r1 = v1 * c1 + (p1 * s1) * sgn; if (rot_lane) { v0 = r0; v1 = r1; } }
                    if (gate) {
#pragma unroll
                        for (int j = 0; j < 4; ++j) { v0[j] = silu_f(v0[j]); v1[j] = silu_f(v1[j]); } }
                    v0 = v0 * sc; v1 = v1 * sc;
                    *(u32x4*)(rowp + bj * HALF) = pack8(v0, v1); } }
    }
};
struct EpiProj1 {
    static constexpr bool PERM = true, AFTER_DRAIN = false;
    bf16_t *U; size_t rstride; float* stats;
    __device__ __forceinline__ void operator()(const f32x4 (&acc)[2][2][4][2], const Unit& u, int wr, int wc, int fr, int fq) const {
        const int row0 = u.pm * BM + wr * 64 + fr, pn = u.pn, reg = pn >> 3;
        bf16_t* base = U + (size_t)reg * rstride; const int col0 = (pn & 7) * 256 + wc * 32 + 8 * fq;
#pragma unroll
        for (int ai = 0; ai < 2; ++ai)
#pragma unroll
            for (int m = 0; m < 4; ++m) { const int row = row0 + ai * HALF + m * 16; bf16_t* rowp = base + (size_t)row * 2048 + col0; float s = 0.f, q = 0.f;
#pragma unroll
                for (int bj = 0; bj < 2; ++bj) { f32x4 v0 = acc[ai][bj][m][0], v1 = acc[ai][bj][m][1];
#pragma unroll
                    for (int j = 0; j < 4; ++j) { if (reg == 2) { v0[j] = silu_f(v0[j]); v1[j] = silu_f(v1[j]); } else { v0[j] = gelu_tanh_f(v0[j]); v1[j] = gelu_tanh_f(v1[j]); } }
                    if (reg == 1) {
#pragma unroll
                        for (int j = 0; j < 4; ++j) { s += v0[j] + v1[j]; q += v0[j] * v0[j] + v1[j] * v1[j]; } }
                    *(u32x4*)(rowp + bj * HALF) = pack8(v0, v1); }
                if (reg == 1) { s += swz_xor<16>(s); s = half_sum(s); q += swz_xor<16>(q); q = half_sum(q);
                    if (fq == 0) { float* sp = stats + ((size_t)row * 32 + (pn - 8) * 4 + wc) * 2; sp[0] = s; sp[1] = q; } } }
    }
};
struct EpiF32 {
    static constexpr bool PERM = true, AFTER_DRAIN = false;
    float* O; int ldc;
    __device__ __forceinline__ void operator()(const f32x4 (&acc)[2][2][4][2], const Unit& u, int wr, int wc, int fr, int fq) const {
        const int row0 = u.pm * BM + wr * 64 + fr, col0 = u.pn * BM + wc * 32 + 8 * fq;
#pragma unroll
        for (int ai = 0; ai < 2; ++ai)
#pragma unroll
            for (int m = 0; m < 4; ++m) { float* rowp = O + (size_t)(row0 + ai * HALF + m * 16) * ldc + col0;
#pragma unroll
                for (int bj = 0; bj < 2; ++bj) { *(f32x4*)(rowp + bj * HALF) = acc[ai][bj][m][0]; *(f32x4*)(rowp + bj * HALF + 4) = acc[ai][bj][m][1]; } }
    }
};
struct EpiPool {
    static constexpr bool PERM = true, AFTER_DRAIN = false;
    bf16_t* Y; const bf16_t* G; const float* scale;
    __device__ __forceinline__ void operator()(const f32x4 (&acc)[2][2][4][2], const Unit& u, int wr, int wc, int fr, int fq) const {
        const int row0 = u.pm * BM + wr * 64 + fr, col0 = u.pn * BM + wc * 32 + 8 * fq;
        f32x4 sv[2][2];
#pragma unroll
        for (int bj = 0; bj < 2; ++bj) { sv[bj][0] = *(const f32x4*)(scale + col0 + bj * HALF); sv[bj][1] = *(const f32x4*)(scale + col0 + bj * HALF + 4); }
#pragma unroll
        for (int ai = 0; ai < 2; ++ai)
#pragma unroll
            for (int m = 0; m < 4; ++m) { const size_t off = (size_t)(row0 + ai * HALF + m * 16) * 2048 + col0;
#pragma unroll
                for (int bj = 0; bj < 2; ++bj) { const u32x4 gw = *(const u32x4*)(G + off + bj * HALF);
                    f32x4 g0, g1; g0[0] = __uint_as_float(gw.x << 16); g0[1] = __uint_as_float(gw.x & 0xffff0000u); g0[2] = __uint_as_float(gw.y << 16); g0[3] = __uint_as_float(gw.y & 0xffff0000u);
                    g1[0] = __uint_as_float(gw.z << 16); g1[1] = __uint_as_float(gw.z & 0xffff0000u); g1[2] = __uint_as_float(gw.w << 16); g1[3] = __uint_as_float(gw.w & 0xffff0000u);
                    const f32x4 v0 = acc[ai][bj][m][0] * sv[bj][0] * g0, v1 = acc[ai][bj][m][1] * sv[bj][1] * g1;
                    *(u32x4*)(Y + off + bj * HALF) = pack8(v0, v1); } }
    }
};

template <class Epi, class Sched, bool ALIGN_EPI = false, bool SP2 = false>
__device__ __forceinline__ void gemm_phase(PG8_LAS unsigned char* lds, const Gemm g, const Sched& S, const Epi& E) {
    int tid_ = threadIdx.x; asm volatile("" : "+v"(tid_));
    const int tid = tid_, wid = __builtin_amdgcn_readfirstlane(tid >> 6), lane = tid & 63, wr = wid >> 2, wc = wid & 3, fr = lane & 15, fq = lane >> 4;
    const int K = g.K, nt = K / BK;
    unsigned voffA[2], voffB[2];
#pragma unroll
    for (int i = 0; i < 2; ++i) { int R, C; stage_rc(tid * 16 + i * 8192, R, C); const int Rb = Epi::PERM ? ((R & ~31) + perm32(R & 31)) : R;
        voffA[i] = (unsigned)(R * g.lda + C) * 2u; voffB[i] = (unsigned)(Rb * g.ldb + C) * 2u; }
    const size_t kstep = (size_t)(BK * 2);
    const size_t hstepA = (size_t)HALF * g.lda * 2, hstepB = (size_t)HALF * g.ldb * 2;
    const size_t tstepA = 2 * hstepA, tstepB = 2 * hstepB, apn = (size_t)g.a_pn_bytes;
    const unsigned ldsw = (unsigned)wid * 1024u;
    const int aoff = lds_byte(wr * 64 + fr, fq * 8), boff = lds_byte(wc * 32 + fr, fq * 8);
#define PG8_SA(b, h) (((b) * 2 + (h)) * HTB)
#define PG8_SB(b, h) ((4 + (b) * 2 + (h)) * HTB)
#define PG8_STAGE(bufoff, gbase, voff) do { _Pragma("unroll") for (int _i = 0; _i < 2; ++_i) \
        __builtin_amdgcn_global_load_lds((const unsigned*)((const char*)(gbase) + (voff)[_i]), (PG8_LAS unsigned*)(lds + (bufoff) + ldsw + _i * 8192), 16, 0, 0); } while (0)
#define PG8_LDA(dst, b, h) do { _Pragma("unroll") for (int m = 0; m < 4; ++m) _Pragma("unroll") for (int k = 0; k < 2; ++k) dst[m][k] = *(const PG8_LAS bf16x8*)(lds + PG8_SA(b, h) + aoff + m * 2048 + k * 1024); } while (0)
#define PG8_LDB(dst, b, h) do { _Pragma("unroll") for (int n = 0; n < 2; ++n) _Pragma("unroll") for (int k = 0; k < 2; ++k) dst[n][k] = *(const PG8_LAS bf16x8*)(lds + PG8_SB(b, h) + boff + n * 2048 + k * 1024); } while (0)
#define PG8_MMA(ai, bj, At, Bt) do { __builtin_amdgcn_s_setprio(1); _Pragma("unroll") for (int m = 0; m < 4; ++m) _Pragma("unroll") for (int n = 0; n < 2; ++n) _Pragma("unroll") for (int k = 0; k < 2; ++k) \
        acc[ai][bj][m][n] = __builtin_amdgcn_mfma_f32_16x16x32_bf16(Bt[n][k], At[m][k], acc[ai][bj][m][n], 0, 0, 0); __builtin_amdgcn_s_setprio(0); } while (0)
#define PG8_WAIT_V(n) asm volatile("s_waitcnt vmcnt(" #n ")" ::: "memory")
#define PG8_WAIT_L(n) asm volatile("s_waitcnt lgkmcnt(" #n ")" ::: "memory")
#define PG8_BAR __builtin_amdgcn_s_barrier()
#define PG8_SCHED __builtin_amdgcn_sched_barrier(0)
    Unit cur, nxt; int ui = 0;
    if (!S.next(0, cur)) return;
    f32x4 acc[2][2][4][2];
#pragma unroll
    for (int a = 0; a < 2; ++a)
#pragma unroll
        for (int b = 0; b < 2; ++b)
#pragma unroll
            for (int m = 0; m < 4; ++m)
#pragma unroll
                for (int n = 0; n < 2; ++n) acc[a][b][m][n] = (f32x4){0.f, 0.f, 0.f, 0.f};
    bf16x8 At[4][2], B0[2][2], B1[2][2];
    const char* cA = (const char*)g.A + (size_t)cur.pm * tstepA + (size_t)cur.pn * apn; const char* cB = (const char*)g.Bt + (size_t)cur.pn * tstepB;
    S.a_ready(cur);
    if constexpr (SP2) {
        PG8_STAGE(PG8_SB(0, 0), cB, voffB); PG8_STAGE(PG8_SB(0, 1), cB + hstepB, voffB); PG8_STAGE(PG8_SA(0, 0), cA, voffA); PG8_STAGE(PG8_SA(0, 1), cA + hstepA, voffA);
        if (wr == 1) PG8_BAR;
        PG8_WAIT_V(2); PG8_BAR;
        PG8_STAGE(PG8_SB(1, 0), cB + kstep, voffB); PG8_STAGE(PG8_SA(1, 0), cA + kstep, voffA); PG8_STAGE(PG8_SB(1, 1), cB + hstepB + kstep, voffB);
        PG8_WAIT_V(6); PG8_BAR;
    } else {
        PG8_STAGE(PG8_SB(0, 0), cB, voffB); PG8_STAGE(PG8_SA(0, 0), cA, voffA); PG8_STAGE(PG8_SB(0, 1), cB + hstepB, voffB); PG8_STAGE(PG8_SA(0, 1), cA + hstepA, voffA);
        if (wr == 1) PG8_BAR;
        PG8_WAIT_V(4); PG8_BAR;
        PG8_STAGE(PG8_SB(1, 0), cB + kstep, voffB); PG8_STAGE(PG8_SA(1, 0), cA + kstep, voffA); PG8_STAGE(PG8_SB(1, 1), cB + hstepB + kstep, voffB);
        PG8_WAIT_V(6); PG8_BAR;
    }
    for (;;) {
        const bool has_next = S.next(ui + 1, nxt);
        const char* nA = has_next ? (const char*)g.A + (size_t)nxt.pm * tstepA + (size_t)nxt.pn * apn : cA; const char* nB = has_next ? (const char*)g.Bt + (size_t)nxt.pn * tstepB : cB;
        for (int t = 0; t < nt; t += 2) {
            const bool last = (t == nt - 2);
            const char* a1 = cA + (size_t)(t + 1) * kstep;
            const char* a2 = last ? nA : cA + (size_t)(t + 2) * kstep; const char* b2 = last ? nB : cB + (size_t)(t + 2) * kstep;
            const char* a3 = a2 + kstep; const char* b3 = b2 + kstep;
            if (last && has_next) S.a_ready(nxt);
            if constexpr (SP2) {
            PG8_LDB(B0, 0, 0); PG8_LDB(B1, 0, 1); PG8_SCHED; PG8_LDA(At, 0, 0); PG8_STAGE(PG8_SA(1, 1), a1 + hstepA, voffA);
            PG8_WAIT_V(8); PG8_WAIT_L(0); PG8_BAR; PG8_MMA(0, 0, At, B0); PG8_MMA(0, 1, At, B1); PG8_BAR; PG8_SCHED;
            PG8_LDA(At, 0, 1); PG8_STAGE(PG8_SB(0, 0), b2, voffB); PG8_STAGE(PG8_SB(0, 1), b2 + hstepB, voffB); PG8_STAGE(PG8_SA(0, 0), a2, voffA);
            PG8_WAIT_V(8); PG8_WAIT_L(0); PG8_BAR; PG8_MMA(1, 0, At, B0); PG8_MMA(1, 1, At, B1); PG8_BAR; PG8_SCHED;
            PG8_LDB(B0, 1, 0); PG8_LDB(B1, 1, 1); PG8_SCHED; PG8_LDA(At, 1, 0); PG8_STAGE(PG8_SA(0, 1), a2 + hstepA, voffA);
            PG8_WAIT_V(8); PG8_WAIT_L(0); PG8_BAR; PG8_MMA(0, 0, At, B0); PG8_MMA(0, 1, At, B1); PG8_BAR; PG8_SCHED;
            PG8_LDA(At, 1, 1); PG8_STAGE(PG8_SB(1, 0), b3, voffB); PG8_STAGE(PG8_SB(1, 1), b3 + hstepB, voffB); PG8_STAGE(PG8_SA(1, 0), a3, voffA);
            PG8_WAIT_V(8); PG8_WAIT_L(0); PG8_BAR; PG8_MMA(1, 0, At, B0); PG8_MMA(1, 1, At, B1); PG8_BAR; PG8_SCHED;
            } else {
            PG8_LDB(B0, 0, 0); PG8_SCHED; PG8_LDA(At, 0, 0); PG8_STAGE(PG8_SA(1, 1), a1 + hstepA, voffA);
            PG8_WAIT_L(8); PG8_BAR; PG8_WAIT_L(0); PG8_MMA(0, 0, At, B0); PG8_BAR; PG8_SCHED;
            PG8_LDB(B1, 0, 1); PG8_STAGE(PG8_SB(0, 0), b2, voffB);
            PG8_BAR; PG8_WAIT_L(0); PG8_MMA(0, 1, At, B1); PG8_BAR;
            PG8_LDA(At, 0, 1); PG8_STAGE(PG8_SA(0, 0), a2, voffA);
            PG8_BAR; PG8_WAIT_L(0); PG8_MMA(1, 0, At, B0); PG8_BAR; PG8_SCHED;
            PG8_STAGE(PG8_SB(0, 1), b2 + hstepB, voffB);
            PG8_WAIT_V(6); PG8_BAR; PG8_MMA(1, 1, At, B1); PG8_BAR;
            PG8_LDB(B0, 1, 0); PG8_SCHED; PG8_LDA(At, 1, 0); PG8_STAGE(PG8_SA(0, 1), a2 + hstepA, voffA);
            PG8_WAIT_L(8); PG8_BAR; PG8_WAIT_L(0); PG8_MMA(0, 0, At, B0); PG8_BAR; PG8_SCHED;
            PG8_LDB(B1, 1, 1); PG8_STAGE(PG8_SB(1, 0), b3, voffB);
            PG8_BAR; PG8_WAIT_L(0); PG8_MMA(0, 1, At, B1); PG8_BAR;
            PG8_LDA(At, 1, 1); PG8_STAGE(PG8_SA(1, 0), a3, voffA);
            PG8_BAR; PG8_WAIT_L(0); PG8_MMA(1, 0, At, B0); PG8_BAR; PG8_SCHED;
            PG8_STAGE(PG8_SB(1, 1), b3 + hstepB, voffB);
            PG8_WAIT_V(6); PG8_BAR; PG8_MMA(1, 1, At, B1); PG8_BAR;
            }
        }
        if constexpr (ALIGN_EPI) { if (wr == 0) PG8_BAR; }
        if constexpr (!Epi::AFTER_DRAIN) { E(acc, cur, wr, wc, fr, fq); S.done(cur); }
        if (!has_next) break;
#pragma unroll
        for (int a = 0; a < 2; ++a)
#pragma unroll
            for (int b = 0; b < 2; ++b)
#pragma unroll
                for (int m = 0; m < 4; ++m)
#pragma unroll
                    for (int n = 0; n < 2; ++n) acc[a][b][m][n] = (f32x4){0.f, 0.f, 0.f, 0.f};
        cur = nxt; cA = nA; cB = nB; ++ui;
        if constexpr (ALIGN_EPI) { if (wr == 1) PG8_BAR; }
    }
    PG8_WAIT_V(0);
    if constexpr (!ALIGN_EPI) { if (wr == 0) PG8_BAR; }
    PG8_BAR;
    if constexpr (Epi::AFTER_DRAIN) { E.fused(acc, cur, wr, wc, fr, fq, lds, wid, lane); S.done(cur); }
#undef PG8_SA
#undef PG8_SB
#undef PG8_STAGE
#undef PG8_LDA
#undef PG8_LDB
#undef PG8_MMA
#undef PG8_WAIT_V
#undef PG8_WAIT_L
#undef PG8_BAR
#undef PG8_SCHED
}
}
#include <hip/hip_bf16.h>
#include <cmath>
namespace attn_body {
using bf16=__hip_bfloat16;
using bf16x8=__attribute__((ext_vector_type(8)))short;
using s16x4=__attribute__((ext_vector_type(4)))short;
using f32x16=__attribute__((ext_vector_type(16)))float;
using u32x4=__attribute__((ext_vector_type(4)))unsigned;
constexpr int BATCH=4,NHEAD=32,SEQ=4096,D=64,PQ=1024,PO=2048;
constexpr int NW=8,QBLK=32,QB=QBLK*NW,KVBLK=64,NQB=SEQ/QB;
constexpr int ATTN_UNIT_ROWS=QB;
__device__ __forceinline__ int crow(int r,int hi){return (r&3)+8*(r>>2)+4*hi;}
#define SBAR() __builtin_amdgcn_sched_barrier(0)
__device__ __forceinline__ void cmask(f32x16&p0,f32x16&p1,int jb,int qrel,int hi){
  const float NEG=-INFINITY; int kb=64*jb+4*hi;
  #pragma unroll
  for(int r=0;r<16;++r){int kv=kb+(r&3)+8*(r>>2); if(kv>qrel)p0[r]=NEG; if(kv+32>qrel)p1[r]=NEG;}
}

constexpr int NSLOT=3, SLOTB=8192;
constexpr int LDS_K=0, LDS_V=NSLOT*SLOTB, LDS_WS=2*NSLOT*SLOTB, LDS_OST=LDS_WS+NW*64*4, LDS_BYTES=LDS_OST+NW*4096;
constexpr float C2=0.125f*1.4426950408889634f;
__device__ __forceinline__ void glds16(const void*gsrc,unsigned lds_dst){unsigned keep;
  asm volatile("s_mov_b32 %0, m0\n\ts_mov_b32 m0, %2\n\ts_nop 0\n\tglobal_load_lds_dwordx4 %1, off\n\ts_mov_b32 m0, %0":"=&s"(keep):"v"(gsrc),"s"(lds_dst):"memory");}
__device__ __forceinline__ float max3f(float a,float b,float c){float r;asm("v_max3_f32 %0, %1, %2, %3":"=v"(r):"v"(a),"v"(b),"v"(c));return r;}
__device__ __forceinline__ float max2f(float a,float b){float r;asm("v_max_f32_e32 %0, %1, %2":"=v"(r):"v"(a),"v"(b));return r;}
__device__ __forceinline__ float fadd_s(float a,float b){float r;asm("v_add_f32_e32 %0, %1, %2":"=v"(r):"v"(a),"v"(b));return r;}
__device__ __forceinline__ float fsub_s(float a,float b){float r;asm("v_sub_f32_e32 %0, %1, %2":"=v"(r):"v"(a),"v"(b));return r;}
typedef float f32x2_t __attribute__((ext_vector_type(2))); typedef __bf16 bf16x2_t __attribute__((ext_vector_type(2)));
__device__ __forceinline__ unsigned cvtpk_s(float lo,float hi){f32x2_t v={lo,hi};bf16x2_t b=__builtin_convertvector(v,bf16x2_t);return __builtin_bit_cast(unsigned,b);}
#define WAIT_BAR(N) asm volatile("s_waitcnt vmcnt(" #N ") lgkmcnt(0)\n\ts_barrier":::"memory")

__device__ __forceinline__ void qkt(f32x16&p0,f32x16&p1,const char*Kslot,const bf16x8*qr,const f32x16&negm,int r32,int hi){
  const char*kb=Kslot+hi*1024+r32*16;
  #pragma unroll
  for(int d0=0;d0<4;++d0){
    const bf16x8 b0=*reinterpret_cast<const bf16x8*>(kb+d0*2048);
    const bf16x8 b1=*reinterpret_cast<const bf16x8*>(kb+d0*2048+512);
    if(d0==0){p0=__builtin_amdgcn_mfma_f32_32x32x16_bf16(b0,qr[0],negm,0,0,0);p1=__builtin_amdgcn_mfma_f32_32x32x16_bf16(b1,qr[0],negm,0,0,0);}
    else{p0=__builtin_amdgcn_mfma_f32_32x32x16_bf16(b0,qr[d0],p0,0,0,0);p1=__builtin_amdgcn_mfma_f32_32x32x16_bf16(b1,qr[d0],p1,0,0,0);}}
}
typedef __attribute__((address_space(3))) const char* lds_cptr;
typedef short v4i16_t __attribute__((ext_vector_type(4)));
__device__ __forceinline__ void kload8(bf16x8*kf,lds_cptr kp){
  kf[0]=*(const __attribute__((address_space(3))) bf16x8*)(kp);      kf[1]=*(const __attribute__((address_space(3))) bf16x8*)(kp+512);
  kf[2]=*(const __attribute__((address_space(3))) bf16x8*)(kp+2048); kf[3]=*(const __attribute__((address_space(3))) bf16x8*)(kp+2560);
  kf[4]=*(const __attribute__((address_space(3))) bf16x8*)(kp+4096); kf[5]=*(const __attribute__((address_space(3))) bf16x8*)(kp+4608);
  kf[6]=*(const __attribute__((address_space(3))) bf16x8*)(kp+6144); kf[7]=*(const __attribute__((address_space(3))) bf16x8*)(kp+6656);
}
__device__ __forceinline__ void kload2(bf16x8*kf,lds_cptr kp,int j){ kf[2*j]=*(const __attribute__((address_space(3))) bf16x8*)(kp+j*2048); kf[2*j+1]=*(const __attribute__((address_space(3))) bf16x8*)(kp+j*2048+512); }
__device__ __forceinline__ s16x4 vtr(lds_cptr p){ return __builtin_bit_cast(s16x4,__builtin_amdgcn_ds_read_tr16_b64_v4i16((__attribute__((address_space(3))) v4i16_t*)p)); }
__device__ __forceinline__ float rowmax(const f32x16&p0,const f32x16&p1){
  float a=max3f(p0[0],p0[1],p1[0]),b=max3f(p0[2],p0[3],p1[1]);a=max3f(a,p1[2],p1[3]);
  #pragma unroll
  for(int r=4;r<16;r+=4){a=max3f(a,p0[r],p0[r+1]);b=max3f(b,p0[r+2],p0[r+3]);a=max3f(a,p1[r],p1[r+1]);b=max3f(b,p1[r+2],p1[r+3]);}
  const float m=max2f(a,b);
  auto rr=__builtin_amdgcn_permlane32_swap(__float_as_uint(m),__float_as_uint(m),false,false);
  return max2f(__uint_as_float(rr[0]),__uint_as_float(rr[1]));
}
__device__ __forceinline__ void pv(f32x16*o,int vb,bf16x8 pa0,bf16x8 pa1,bf16x8 pa2,bf16x8 pa3){
  #pragma unroll
  for(int d0=0;d0<2;++d0){s16x4 lo[4],hi[4];
    #pragma unroll
    for(int ks=0;ks<4;++ks){
      asm volatile("ds_read_b64_tr_b16 %0,%1 offset:%c2":"=&v"(lo[ks]):"v"(vb),"i"(d0*4096+ks*1024):"memory");
      asm volatile("ds_read_b64_tr_b16 %0,%1 offset:%c2":"=&v"(hi[ks]):"v"(vb),"i"(d0*4096+ks*1024+512):"memory");}
    asm volatile("s_waitcnt lgkmcnt(0)":::"memory");SBAR();
    #define PK(k) (bf16x8){lo[k][0],lo[k][1],lo[k][2],lo[k][3],hi[k][0],hi[k][1],hi[k][2],hi[k][3]}
    o[d0]=__builtin_amdgcn_mfma_f32_32x32x16_bf16(pa0,PK(0),o[d0],0,0,0);
    o[d0]=__builtin_amdgcn_mfma_f32_32x32x16_bf16(pa1,PK(1),o[d0],0,0,0);
    o[d0]=__builtin_amdgcn_mfma_f32_32x32x16_bf16(pa2,PK(2),o[d0],0,0,0);
    o[d0]=__builtin_amdgcn_mfma_f32_32x32x16_bf16(pa3,PK(3),o[d0],0,0,0);
    #undef PK
  }
}

#ifndef ATTN_STORE16
#define ATTN_STORE16(p,v) (*(u32x4*)(p)=(v))
#endif
template<int THRL> __device__ __forceinline__ void attn_unit(int b,int vh,int qb,const bf16*Q,const bf16*__restrict__ K,const bf16*__restrict__ V,bf16*O,char*shm){
  int tid_=threadIdx.x; asm volatile("":"+v"(tid_)); const int tid=tid_,lane=tid&63,r32=lane&31,hi=lane>>5; const int wid=__builtin_amdgcn_readfirstlane(tid>>6);
  const long rowbase=(long)b*SEQ; const int q0=qb*QB;
  const int qcol=(vh>>2)*128+((vh>>1)&1)*64, vcol=(vh>>2)*128+(vh&1)*64, ocol=vh*64;
  const bf16*Qw=Q+(rowbase+q0+wid*QBLK)*PQ+qcol;
  const bf16*Kh=K+rowbase*PQ+qcol,*Vh=V+rowbase*PQ+vcol;
  const unsigned lds0=(unsigned)(uintptr_t)shm;
  float*wsf=(float*)(shm+LDS_WS)+wid*64;
  const bf16*ksrc=Kh+(long)lane*PQ+wid*8;
  const bf16*vsrc=Vh+(long)(16*(wid&3)+(lane>>2))*PQ+(wid>>2)*32+(lane&3)*8;
  const unsigned kdst=lds0+LDS_K+wid*1024, vdst=lds0+LDS_V+wid*1024;
  #define DMA_K(t,slot) glds16(ksrc+(long)(t)*KVBLK*PQ,(unsigned)__builtin_amdgcn_readfirstlane(kdst+(slot)))
  #define DMA_V(t,slot) glds16(vsrc+(long)(t)*KVBLK*PQ,(unsigned)__builtin_amdgcn_readfirstlane(vdst+(slot)))
  const int vb0=(int)(lds0+LDS_V)+((lane>>4)&1)*32+(lane&3)*8+(4*hi+((lane&15)>>2))*64;
  const char*Kbase=shm+LDS_K; bf16x8 kf[8];
  const lds_cptr shm3=(lds_cptr)shm; const lds_cptr kp0=shm3+LDS_K+hi*1024+r32*16; const lds_cptr vp0=shm3+LDS_V+((lane>>4)&1)*32+(lane&3)*8+(4*hi+((lane&15)>>2))*64;
  const int NT=(q0+QB)/KVBLK;
  DMA_K(0,0);DMA_V(0,0);DMA_K(1,SLOTB);
  bf16x8 qr[4];
  #pragma unroll
  for(int d0=0;d0<4;++d0)qr[d0]=*reinterpret_cast<const bf16x8*>(&Qw[(long)r32*PQ+d0*16+hi*8]);
  float mhat=0.f,l_reg=0.f;f32x16 o[2];o[0]=f32x16{};o[1]=f32x16{};f32x16 negm=f32x16{};asm volatile("":"+v"(negm));
  const int qrel=wid*QBLK+r32;
  #define CMASK(P0,P1,t) do{int jb_=(t)-(NT-4); if(jb_>=0)cmask(P0,P1,jb_,qrel,hi);}while(0)
  bool resc=false;
  #define START(P0,P1) do{ const float rm=rowmax(P0,P1); resc=false; \
    { const float dl=rm; mhat=fadd_s(mhat,dl); \
      _Pragma("unroll") for(int r=0;r<16;++r){P0[r]=fsub_s(P0[r],dl);P1[r]=fsub_s(P1[r],dl);} \
      _Pragma("unroll") for(int r=0;r<16;++r)negm[r]=-mhat; asm volatile("":"+v"(negm)); } \
    _Pragma("unroll") for(int r=0;r<16;++r)P0[r]=__builtin_amdgcn_exp2f(P0[r]); }while(0)
  #define RESC() do{ if(resc){ asm volatile("s_waitcnt lgkmcnt(0)":::"memory"); \
      _Pragma("unroll") for(int d_=0;d_<2;++d_) _Pragma("unroll") for(int r=0;r<16;++r)o[d_][r]*=wsf[crow(r,hi)]; } }while(0)
  f32x16 pA0,pA1,pB0,pB1;
  int sl_prev=0,sl_cur=0,sl_next=SLOTB;
  #define ROT() do{sl_prev=sl_cur;sl_cur=sl_next;sl_next=(sl_next==(NSLOT-1)*SLOTB)?0:sl_next+SLOTB;}while(0)
  DMA_K(2,2*SLOTB);
  WAIT_BAR(3);
  qkt(pA0,pA1,Kbase,qr,negm,r32,hi);asm volatile("s_nop 15\n\ts_nop 7":"+v"(pA0),"+v"(pA1));CMASK(pA0,pA1,0);
  START(pA0,pA1);
  _Pragma("unroll") for(int r=0;r<16;++r)pA1[r]=__builtin_amdgcn_exp2f(pA1[r]);
  WAIT_BAR(0);
  DMA_K(3,0);DMA_V(1,SLOTB);
  ROT();
  kload8(kf,kp0+sl_cur);
  WAIT_BAR(2);
  s16x4 vlo[8],vhi[8]; u32x4 pw0,pw1,pw2,pw3;
  #define PKW(P,B) cvtpk_s(P[B],P[B+1])
  #define PAF(k) __builtin_bit_cast(bf16x8,pw##k)
  #define VFR(i) (bf16x8){vlo[i][0],vlo[i][1],vlo[i][2],vlo[i][3],vhi[i][0],vhi[i][1],vhi[i][2],vhi[i][3]}
  #define PIN(x) asm volatile("":"+v"(x))
  #define MX3(a,b,c) __builtin_fmaxf(__builtin_fmaxf((a),(b)),(c))
  #define GAPA(MF,A0,A1,A2,A3,W0,W1,PW) do{ MF; sacc+=A0; sacc+=A1; sacc+=A2; sacc+=A3; PIN(sacc); W0; W1; PIN(PW); SBAR(); }while(0)
  #define EX(v) __builtin_amdgcn_exp2f(v)
  #define GAPB(MF,X,B) do{ MF; X[B]=EX(X[B]); X[B+1]=EX(X[B+1]); X[B+2]=EX(X[B+2]); X[B+3]=EX(X[B+3]); PIN(X); SBAR(); }while(0)
  #define VRD(i) do{ vlo[i]=vtr(vp_+(((i)>>2)*4096+((i)&3)*1024)); vhi[i]=vtr(vp_+(((i)>>2)*4096+((i)&3)*1024+512)); }while(0)
  #define KRD(G,j) do{ if(G){ kload2(kf,kp0+sl_next,j); SBAR(); } }while(0)
  #define STEP(C0,C1,P0,P1,t,GK,GV,GL) do{ SBAR(); \
    const lds_cptr vp_=vp0+sl_prev; \
    VRD(0); SBAR(); float sacc=(P0[0]+P0[1]); \
    GAPA(C0=__builtin_amdgcn_mfma_f32_32x32x16_bf16(kf[0],qr[0],negm,0,0,0), P0[2],P0[3],P0[4],P0[5],     pw0[0]=PKW(P0,0), pw0[1]=PKW(P0,2), pw0); \
    VRD(4); SBAR(); GAPA(C1=__builtin_amdgcn_mfma_f32_32x32x16_bf16(kf[1],qr[0],negm,0,0,0), P0[6],P0[7],P0[8],P0[9],     pw0[2]=PKW(P0,4), pw0[3]=PKW(P0,6), pw0); \
    VRD(1); SBAR(); GAPA(C0=__builtin_amdgcn_mfma_f32_32x32x16_bf16(kf[2],qr[1],C0,0,0,0),   P0[10],P0[11],P0[12],P0[13], pw1[0]=PKW(P0,8), pw1[1]=PKW(P0,10), pw1); \
    VRD(5); SBAR(); GAPA(C1=__builtin_amdgcn_mfma_f32_32x32x16_bf16(kf[3],qr[1],C1,0,0,0),   P0[14],P0[15],P1[0],P1[1],   pw1[2]=PKW(P0,12),pw1[3]=PKW(P0,14), pw1); \
    VRD(2); SBAR(); GAPA(C0=__builtin_amdgcn_mfma_f32_32x32x16_bf16(kf[4],qr[2],C0,0,0,0),   P1[2],P1[3],P1[4],P1[5],     pw2[0]=PKW(P1,0), pw2[1]=PKW(P1,2), pw2); \
    VRD(6); SBAR(); GAPA(C1=__builtin_amdgcn_mfma_f32_32x32x16_bf16(kf[5],qr[2],C1,0,0,0),   P1[6],P1[7],P1[8],P1[9],     pw2[2]=PKW(P1,4), pw2[3]=PKW(P1,6), pw2); \
    VRD(3); SBAR(); GAPA(C0=__builtin_amdgcn_mfma_f32_32x32x16_bf16(kf[6],qr[3],C0,0,0,0),   P1[10],P1[11],P1[12],P1[13], pw3[0]=PKW(P1,8), pw3[1]=PKW(P1,10), pw3); \
    VRD(7); SBAR(); GAPA(C1=__builtin_amdgcn_mfma_f32_32x32x16_bf16(kf[7],qr[3],C1,0,0,0),   P1[14],P1[15],0.f,0.f,       pw3[2]=PKW(P1,12),pw3[3]=PKW(P1,14), pw3); \
    l_reg+=sacc; \
    if(GK){DMA_K((t)+3,sl_cur);} if(GV){DMA_V((t)+1,sl_next);} \
    CMASK(C0,C1,t); \
    { float a=MX3(C0[0],C0[1],C1[0]),b=MX3(C0[2],C0[3],C1[1]); a=MX3(a,C1[2],C1[3]); \
      _Pragma("unroll") for(int r=4;r<16;r+=4){a=MX3(a,C0[r],C0[r+1]);b=MX3(b,C0[r+2],C0[r+3]);a=MX3(a,C1[r],C1[r+1]);b=MX3(b,C1[r+2],C1[r+3]);} \
      float rm=__builtin_fmaxf(a,b); { auto rr=__builtin_amdgcn_permlane32_swap(__float_as_uint(rm),__float_as_uint(rm),false,false); rm=__builtin_fmaxf(__uint_as_float(rr[0]),__uint_as_float(rr[1])); } \
      resc=false; \
      if(__builtin_expect(__any(rm>(float)THRL),0)){ const float dl=__builtin_fmaxf(rm,0.f); mhat+=dl; \
        _Pragma("unroll") for(int r=0;r<16;++r){C0[r]-=dl;C1[r]-=dl;} \
        _Pragma("unroll") for(int r=0;r<16;++r)negm[r]=-mhat; asm volatile("":"+v"(negm)); \
        const float f=__builtin_amdgcn_exp2f(-dl); l_reg*=f; if(hi==0)wsf[r32]=f; resc=true; } } \
    SBAR(); \
    GAPB(o[0]=__builtin_amdgcn_mfma_f32_32x32x16_bf16(PAF(0),VFR(0),o[0],0,0,0), C0,0); \
    GAPB(o[1]=__builtin_amdgcn_mfma_f32_32x32x16_bf16(PAF(0),VFR(4),o[1],0,0,0), C0,4); \
    KRD(GL,0); GAPB(o[0]=__builtin_amdgcn_mfma_f32_32x32x16_bf16(PAF(1),VFR(1),o[0],0,0,0), C0,8); \
    KRD(GL,1); GAPB(o[1]=__builtin_amdgcn_mfma_f32_32x32x16_bf16(PAF(1),VFR(5),o[1],0,0,0), C0,12); \
    KRD(GL,2); GAPB(o[0]=__builtin_amdgcn_mfma_f32_32x32x16_bf16(PAF(2),VFR(2),o[0],0,0,0), C1,0); \
    KRD(GL,3); GAPB(o[1]=__builtin_amdgcn_mfma_f32_32x32x16_bf16(PAF(2),VFR(6),o[1],0,0,0), C1,4); \
    GAPB(o[0]=__builtin_amdgcn_mfma_f32_32x32x16_bf16(PAF(3),VFR(3),o[0],0,0,0), C1,8); \
    GAPB(o[1]=__builtin_amdgcn_mfma_f32_32x32x16_bf16(PAF(3),VFR(7),o[1],0,0,0), C1,12); \
    }while(0)
  int t=1;
  #undef CMASK
  #define CMASK(P0,P1,t) do{}while(0)
  for(;t+5<NT;t+=2){
    STEP(pB0,pB1,pA0,pA1,t,true,true,true);     WAIT_BAR(2); RESC(); ROT();
    STEP(pA0,pA1,pB0,pB1,t+1,true,true,true);   WAIT_BAR(2); RESC(); ROT();
  }
  #undef CMASK
  #define CMASK(P0,P1,t) do{int jb_=(t)-(NT-4); if(jb_>=0)cmask(P0,P1,jb_,qrel,hi);}while(0)
  #define ENDW(tt) do{ if((tt)+3<NT){WAIT_BAR(2);} else if((tt)+2<NT){WAIT_BAR(1);} else {WAIT_BAR(0);} }while(0)
  for(;t+1<NT;t+=2){
    STEP(pB0,pB1,pA0,pA1,t,(t+3<NT),(t+1<NT),(t+1<NT));       ENDW(t);   RESC(); ROT();
    STEP(pA0,pA1,pB0,pB1,t+1,(t+4<NT),(t+2<NT),(t+2<NT));     ENDW(t+1); RESC(); ROT();
  }
  STEP(pB0,pB1,pA0,pA1,NT-1,false,false,false); RESC();
  { float sacc=pB0[0]+pB0[1]; _Pragma("unroll") for(int r=2;r<16;++r)sacc+=pB0[r]; _Pragma("unroll") for(int r=0;r<16;++r)sacc+=pB1[r]; l_reg+=sacc;
    pw0=(u32x4){PKW(pB0,0),PKW(pB0,2),PKW(pB0,4),PKW(pB0,6)};pw1=(u32x4){PKW(pB0,8),PKW(pB0,10),PKW(pB0,12),PKW(pB0,14)};pw2=(u32x4){PKW(pB1,0),PKW(pB1,2),PKW(pB1,4),PKW(pB1,6)};pw3=(u32x4){PKW(pB1,8),PKW(pB1,10),PKW(pB1,12),PKW(pB1,14)};
    SBAR(); pv(o,vb0+sl_cur,PAF(0),PAF(1),PAF(2),PAF(3)); }
  #undef PKW
  #undef PAF
  #undef VFR
  #undef PIN
  #undef MX3
  #undef GAPA
  #undef GAPB
  #undef EX
  #undef VRD
  #undef KRD
  #undef STEP
  #undef ENDW
  {auto rr=__builtin_amdgcn_permlane32_swap(__float_as_uint(l_reg),__float_as_uint(l_reg),false,false);l_reg=__uint_as_float(rr[0])+__uint_as_float(rr[1]);}
  if(hi==0)wsf[32+r32]=l_reg;asm volatile("s_waitcnt lgkmcnt(0)":::"memory");
  float rli[16];
  #pragma unroll
  for(int r=0;r<16;++r)rli[r]=__builtin_amdgcn_rcpf(wsf[32+crow(r,hi)]);
  bf16*Ow=O+(rowbase+q0+wid*QBLK)*PO+ocol;
  { bf16*stg=(bf16*)(shm+LDS_OST)+wid*2048;
    #pragma unroll
    for(int r=0;r<16;++r){const int orow=crow(r,hi);
      #pragma unroll
      for(int d0=0;d0<2;++d0)stg[orow*64+d0*32+r32]=__float2bfloat16(o[d0][r]*rli[r]);}
    asm volatile("s_waitcnt lgkmcnt(0)":::"memory");
    #pragma unroll
    for(int i=0;i<4;++i){const int row=i*8+(lane>>3),ch=lane&7; const u32x4 v=*(const u32x4*)(stg+row*64+ch*8); ATTN_STORE16(Ow+(long)row*PO+ch*8,v);} }
  asm volatile("s_waitcnt lgkmcnt(0)\n\ts_barrier":::"memory");
  #undef DMA_K
  #undef DMA_V
  #undef CMASK
  #undef START
  #undef RESC
  #undef ROT
}
constexpr int ATTN_LDS_BYTES=LDS_BYTES;
struct AttnTensors { const bf16* Q; const bf16* K; const bf16* V; bf16* O; };
struct AttnUnit { int bh; int qb; };
struct StaticOrder {
  int vcu, G;
  __device__ __forceinline__ explicit StaticOrder(int grid,int block):vcu((grid%8==0)?(block%8)*(grid/8)+block/8:block),G(grid){}
  __device__ __forceinline__ bool next(int i,AttnUnit&u)const{
    if(G==256){ if(i>=8)return false; const int s=vcu&1; u.bh=vcu>>1; u.qb=2*i+((i&1)^s); return true; }
    const int L=i*G+vcu; if(L>=BATCH*NHEAD*NQB)return false; u.bh=L/NQB; u.qb=NQB-1-(L%NQB); return true; }
  __device__ __forceinline__ void a_ready(const AttnUnit&)const{}
  __device__ __forceinline__ void done(const AttnUnit&)const{}
};
template<class Sched,int THRL=8> __device__ __forceinline__ void attn_phase(char*lds,const AttnTensors&T,const Sched&S){
  AttnUnit u;
  for(int i=0;S.next(i,u);++i){ S.a_ready(u); attn_unit<THRL>(u.bh/NHEAD,u.bh%NHEAD,u.qb,T.Q,T.K,T.V,T.O,lds); S.done(u); }
}
#undef SBAR
#undef WAIT_BAR
}
namespace cg = cooperative_groups;
#ifndef REP_P0
#define REP_P0 1
#endif
#ifndef REP_P1
#define REP_P1 1
#endif
#ifndef REP_P2
#define REP_P2 1
#endif
#ifndef REP_P2b
#define REP_P2b 1
#endif
#ifndef REP_P2c
#define REP_P2c 1
#endif
#ifndef REP_P3
#define REP_P3 1
#endif
#ifndef REP_P3b
#define REP_P3b 1
#endif
#ifndef REP_P4
#define REP_P4 1
#endif
#ifndef REP_P6
#define REP_P6 1
#endif
#ifndef EXTRA_SYNCS
#define EXTRA_SYNCS 0
#endif

#ifndef PG_ALIGN
#define PG_ALIGN true
#endif
#ifndef PG_SP2
#define PG_SP2 true
#endif
constexpr int NWAVES = 8;
constexpr int BATCH = 4, SEQ = 4096, DMODEL = 1024, DIN = 2048, INCOLS = 6144, M = BATCH * SEQ;
constexpr size_t MiB = 1u << 20;
constexpr size_t WS_BAR = 16384;
constexpr size_t WS_WIN = 1 * MiB;
constexpr size_t WS_WOUT = 13 * MiB;
constexpr size_t WS_POOLW = 17 * MiB;
constexpr size_t WS_ROPE = 17 * MiB + 512 * 1024;
constexpr size_t WS_A = 19 * MiB;
constexpr size_t WS_Q = 51 * MiB, WS_K = 83 * MiB, WS_V = 115 * MiB;
constexpr size_t WS_Y = 51 * MiB;
constexpr size_t WS_XN = 147 * MiB;
constexpr size_t WS_O = 179 * MiB;
constexpr size_t WS_OUT0 = 179 * MiB;
constexpr size_t WS_STATS = 51 * MiB;
constexpr size_t WS_U = 56 * MiB, WS_V1 = 120 * MiB, WS_G1 = 184 * MiB;
constexpr size_t WS_OUT1 = 120 * MiB;
constexpr size_t WS_END = 248 * MiB;
constexpr int LDS_BYTES = 147456;
#define GAS __attribute__((address_space(1)))
#define LAS __attribute__((address_space(3)))
typedef unsigned short bf16;
typedef unsigned v4u __attribute__((ext_vector_type(4)));
typedef unsigned v2u __attribute__((ext_vector_type(2)));
typedef float f32x4 __attribute__((ext_vector_type(4)));
typedef short bf16x8 __attribute__((ext_vector_type(8)));
#define LDS_WAIT() asm volatile("s_waitcnt lgkmcnt(0)" ::: "memory")
__device__ __forceinline__ unsigned f2bf(float f) { unsigned u = __builtin_bit_cast(unsigned, f); return (u + 0x7fffu + ((u >> 16) & 1u)) >> 16; }
__device__ __forceinline__ unsigned pk2(float lo, float hi) { return pg8::cvt_pk_bf16(lo, hi); }
__device__ __forceinline__ float bflo(unsigned w) { return __uint_as_float(w << 16); }
__device__ __forceinline__ float bfhi(unsigned w) { return __uint_as_float(w & 0xffff0000u); }
__device__ __forceinline__ float wave_sum(float v) {
    v += pg8::swz_xor<1>(v); v += pg8::swz_xor<2>(v); v += pg8::swz_xor<4>(v); v += pg8::swz_xor<8>(v); v += pg8::swz_xor<16>(v);
    return pg8::half_sum(v);
}
#define XB_TMO      128
#define XB_XCNT(j)  (256  + 64 * (j))
#define XB_XSUB(j)  (1280 + 64 * (j))
#define XB_XGEN(j)  (2304 + 64 * (j))
#define XB_TOP      3328
#define XB_TOPGEN   3392
#define XCD_BAR_WORDS 3456
#define XB_SPIN_CAP (1u << 18)

__device__ __forceinline__ unsigned xb_ld(unsigned* p)              { return __hip_atomic_load(p, __ATOMIC_RELAXED, __HIP_MEMORY_SCOPE_AGENT); }
__device__ __forceinline__ unsigned xb_add(unsigned* p, unsigned v) { return __hip_atomic_fetch_add(p, v, __ATOMIC_RELAXED, __HIP_MEMORY_SCOPE_AGENT); }
__device__ __forceinline__ unsigned xb_xcc_id() { return (unsigned)__builtin_amdgcn_s_getreg((3 << 11) | 20) & 0xFu; }
#define XB_SPIN(cond, bar) do { unsigned _sp = 0; while (cond) { __builtin_amdgcn_s_sleep(1); \
    if ((++_sp & 255u) == 0u) { if (xb_ld(&(bar)[XB_TMO])) break; if (_sp > XB_SPIN_CAP) { atomicAdd(&(bar)[XB_TMO], 1u); break; } } } } while (0)

struct XcdBarrier {
    unsigned* bar; unsigned x;
    volatile LAS unsigned* st;
};

__device__ __forceinline__ XcdBarrier xcd_barrier_post(unsigned* bar, volatile LAS unsigned* st) {
    XcdBarrier b; b.bar = bar; b.x = xb_xcc_id(); b.st = st;
    if (threadIdx.x == 0) (void)xb_add(&bar[XB_XCNT(b.x)], 1u);
    return b;
}
__device__ __forceinline__ void xcd_barrier_complete(unsigned* bar, unsigned x, unsigned& nloc, unsigned& nx) {
    const unsigned G = gridDim.x * gridDim.y * gridDim.z;
    unsigned sum, cnt, mine, sp = 0u;
    for (;;) {
        sum = 0u; cnt = 0u; mine = 0u;
#pragma unroll
        for (unsigned j = 0; j < 16; ++j) { const unsigned c = xb_ld(&bar[XB_XCNT(j)]); sum += c; cnt += (c > 0u) ? 1u : 0u; mine = (j == x) ? c : mine; }
        if (sum == G) break;
        __builtin_amdgcn_s_sleep(1);
        if ((++sp & 255u) == 0u) { if (xb_ld(&bar[XB_TMO])) break; if (sp > XB_SPIN_CAP) { atomicAdd(&bar[XB_TMO], 1u); break; } }
    }
    nloc = mine > 0u ? mine : 1u; nx = cnt > 0u ? cnt : 1u;
}

__device__ __forceinline__ void xcd_barrier(const XcdBarrier& b) {
    asm volatile("s_waitcnt vmcnt(0)" ::: "memory");
    __syncthreads();
    if (threadIdx.x == 0) {
        unsigned* bar = b.bar;
        __builtin_amdgcn_s_waitcnt(0);
        unsigned nloc = b.st[0], nx = b.st[1];
        if (nloc == 0u) { xcd_barrier_complete(bar, b.x, nloc, nx); b.st[0] = nloc; b.st[1] = nx; }
        const unsigned old = xb_add(&bar[XB_XSUB(b.x)], 1u);
        const unsigned gen = old / nloc;
        if (old + 1u == (gen + 1u) * nloc) {
            __builtin_amdgcn_fence(__ATOMIC_RELEASE, "agent");
            asm volatile("s_waitcnt vmcnt(0)" ::: "memory");
            const unsigned og = xb_add(&bar[XB_TOP], 1u);
            const unsigned tg = og / nx;
            if (og + 1u == (tg + 1u) * nx) xb_add(&bar[XB_TOPGEN], 1u);
            else XB_SPIN(xb_ld(&bar[XB_TOPGEN]) == tg, bar);
            __builtin_amdgcn_fence(__ATOMIC_ACQUIRE, "agent");
            xb_add(&bar[XB_XGEN(b.x)], 1u);
            asm volatile("s_waitcnt vmcnt(0)" ::: "memory");
        } else {
            XB_SPIN(xb_ld(&bar[XB_XGEN(b.x)]) == gen, bar);
            __builtin_amdgcn_fence(__ATOMIC_ACQUIRE, "agent");
            asm volatile("s_waitcnt vmcnt(0)" ::: "memory");
        }
    }
    __syncthreads();
}
struct Frame { LAS unsigned char* lds; int tid, lane, wave, vcu, G; };
__device__ __forceinline__ unsigned long long ldp(LAS unsigned long long* PT, int k) { asm volatile("" ::: "memory"); const unsigned long long v = PT[k]; const unsigned lo = __builtin_amdgcn_readfirstlane((unsigned)v), hi = __builtin_amdgcn_readfirstlane((unsigned)(v >> 32)); return ((unsigned long long)hi << 32) | lo; }

__device__ __forceinline__ void p0_transpose_item(const float* W, int K, int N, bf16* WT, int row_off, LAS float* scr, int item, int lane) {
    const int nblk = N / 32, kb = item / nblk, nb = item % nblk, k0 = 64 * kb, n0 = 32 * nb;
#pragma unroll 8
    for (int i = 0; i < 32; ++i) { const int kk = 2 * i + (lane >> 5); scr[kk * 33 + (lane & 31)] = W[(size_t)(k0 + kk) * N + n0 + (lane & 31)]; }
    LDS_WAIT(); asm volatile("" ::: "memory");
    const int c = lane & 7;
#pragma unroll
    for (int j = 0; j < 4; ++j) { const int n = (lane >> 3) + 8 * j; const LAS float* s = scr + (8 * c) * 33 + n;
        v4u o; o.x = pk2(s[0 * 33], s[1 * 33]); o.y = pk2(s[2 * 33], s[3 * 33]); o.z = pk2(s[4 * 33], s[5 * 33]); o.w = pk2(s[6 * 33], s[7 * 33]);
        *(v4u*)(WT + (size_t)(row_off + n0 + n) * K + k0 + 8 * c) = o; }
    LDS_WAIT(); asm volatile("" ::: "memory");
}
__device__ __forceinline__ void rms_row_to_bf16(const float* xrow, const float* gain, bf16* orow, int lane) {
    const f32x4* xr = (const f32x4*)xrow + lane; const f32x4* gr = (const f32x4*)gain + lane;
    f32x4 v[4]; float s = 0.f;
#pragma unroll
    for (int j = 0; j < 4; ++j) { v[j] = xr[64 * j]; s += (v[j].x * v[j].x + v[j].y * v[j].y) + (v[j].z * v[j].z + v[j].w * v[j].w); }
    const float rstd = 1.f / sqrtf(wave_sum(s) * (1.f / DMODEL) + 1e-6f);
    v2u* o8 = (v2u*)orow + lane;
#pragma unroll
    for (int j = 0; j < 4; ++j) { const f32x4 g = gr[64 * j]; v2u w; w.x = pk2(v[j].x * rstd * g.x, v[j].y * rstd * g.y); w.y = pk2(v[j].z * rstd * g.z, v[j].w * rstd * g.w); o8[64 * j] = w; }
}
template <bool NEXT> __device__ __forceinline__ void post_row(const float* orow, const float* xin, const float* gpost, float* xout, const float* gpre, bf16* xn, int lane) {
    const f32x4* pr = (const f32x4*)orow + lane; const f32x4* xr = (const f32x4*)xin + lane; const f32x4* gr = (const f32x4*)gpost + lane;
    f32x4 v[4]; float s = 0.f;
#pragma unroll
    for (int j = 0; j < 4; ++j) { v[j] = pr[64 * j]; s += (v[j].x * v[j].x + v[j].y * v[j].y) + (v[j].z * v[j].z + v[j].w * v[j].w); }
    const float rstd = 1.f / sqrtf(wave_sum(s) * (1.f / DMODEL) + 1e-6f); float s2 = 0.f;
#pragma unroll
    for (int j = 0; j < 4; ++j) { v[j] = xr[64 * j] + v[j] * rstd * gr[64 * j]; ((f32x4*)xout + lane)[64 * j] = v[j]; s2 += (v[j].x * v[j].x + v[j].y * v[j].y) + (v[j].z * v[j].z + v[j].w * v[j].w); }
    if (NEXT) { const float r2 = 1.f / sqrtf(wave_sum(s2) * (1.f / DMODEL) + 1e-6f); const f32x4* g2 = (const f32x4*)gpre + lane; v2u* o8 = (v2u*)xn + lane;
#pragma unroll
        for (int j = 0; j < 4; ++j) { const f32x4 g = g2[64 * j]; v2u w; w.x = pk2(v[j].x * r2 * g.x, v[j].y * r2 * g.y); w.y = pk2(v[j].z * r2 * g.z, v[j].w * r2 * g.w); o8[64 * j] = w; } }
}
__device__ __forceinline__ void combine_row(const bf16* O, const bf16* G, const float* subln, bf16* Y, int row, float lam, int lane) {
    const int h = lane >> 3, j = lane & 7;
    const v4u* p0 = (const v4u*)(O + (size_t)row * 2048 + h * 256 + j * 16); const v4u* p1 = (const v4u*)(O + (size_t)row * 2048 + h * 256 + 128 + j * 16);
    const v4u a0 = p0[0], a1 = p0[1], b0 = p1[0], b1 = p1[1];
    float d[16];
#pragma unroll
    for (int k = 0; k < 4; ++k) { d[2 * k] = bflo(a0[k]) - lam * bflo(b0[k]); d[2 * k + 1] = bfhi(a0[k]) - lam * bfhi(b0[k]); d[8 + 2 * k] = bflo(a1[k]) - lam * bflo(b1[k]); d[8 + 2 * k + 1] = bfhi(a1[k]) - lam * bfhi(b1[k]); }
    float ss = 0.f;
#pragma unroll
    for (int k = 0; k < 16; ++k) ss += d[k] * d[k];
    ss += pg8::swz_xor<1>(ss); ss += pg8::swz_xor<2>(ss); ss += pg8::swz_xor<4>(ss);
    const float rstd = 0.8f / sqrtf(ss * (1.f / 128.f) + 1e-5f);
    const v4u* gp = (const v4u*)(G + (size_t)row * 2048 + 1024 + h * 128 + j * 16); const v4u g0 = gp[0], g1 = gp[1];
    const f32x4* sp = (const f32x4*)(subln + j * 16); const f32x4 s0 = sp[0], s1 = sp[1], s2 = sp[2], s3 = sp[3];
    const float sl[16] = {s0.x, s0.y, s0.z, s0.w, s1.x, s1.y, s1.z, s1.w, s2.x, s2.y, s2.z, s2.w, s3.x, s3.y, s3.z, s3.w};
    v4u o0, o1;
#pragma unroll
    for (int k = 0; k < 4; ++k) { o0[k] = pk2(d[2 * k] * rstd * sl[2 * k] * bflo(g0[k]), d[2 * k + 1] * rstd * sl[2 * k + 1] * bfhi(g0[k]));
        o1[k] = pk2(d[8 + 2 * k] * rstd * sl[8 + 2 * k] * bflo(g1[k]), d[8 + 2 * k + 1] * rstd * sl[8 + 2 * k + 1] * bfhi(g1[k])); }
    v4u* yp = (v4u*)(Y + (size_t)row * 2048 + 1024 + h * 128 + j * 16); yp[0] = o0; yp[1] = o1;
}
#ifdef PROBE_NOSKIP
#define SGU_TB0(ks) 0
#else
#define SGU_TB0(ks) (2 * (ks))
#endif
#ifndef ATT_THRL
#define ATT_THRL 8
#endif
constexpr int SG_W = 0, SG_VT = 34816, SG_ST = 34816 + 69632, SG_STRIDE = 272, SG_MSTRIDE = 528;
__device__ __forceinline__ void sgu_unit(const Frame& F, int ch, int g, bf16* U, const bf16* V, const bf16* G, const float* stats, const bf16* Wm, const float* lng, const float* lnb, const float* sgub) {
    LAS unsigned char* lds = F.lds; const int tid = F.tid, lane = F.lane, wave = F.wave; const int row0 = ch * 128;
    LAS float* ST = (LAS float*)(lds + SG_ST);
    if (tid < 128) { const f32x4* p = (const f32x4*)(stats + (size_t)(row0 + tid) * 64); float s = 0.f, q = 0.f;
#ifdef PROBE_STATS
        for (int k = 0; k < 256; ++k) { const v4u r = *(const v4u*)(V + (size_t)(row0 + tid) * 2048 + k * 8);
#pragma unroll
            for (int e = 0; e < 4; ++e) { const float lo = bflo(r[e]), hi = bfhi(r[e]); s += lo + hi; q += lo * lo + hi * hi; } }
#else
#pragma unroll
        for (int k = 0; k < 16; ++k) { const f32x4 t = p[k]; s += t.x + t.z; q += t.y + t.w; }
#endif
        const float mu = s * (1.f / 2048.f), var = q * (1.f / 2048.f) - mu * mu; ST[2 * tid] = mu; ST[2 * tid + 1] = 1.f / sqrtf(var + 1e-6f); }
#pragma unroll
    for (int i = 0; i < 4; ++i) { const int c = tid + 512 * i, t = c >> 4, k8 = c & 15; const v4u w = *(const v4u*)(Wm + (size_t)(g * 128 + t) * 128 + k8 * 8); *(LAS v4u*)(lds + SG_W + t * SG_STRIDE + k8 * 16) = w; }
    __syncthreads();
    { const int db = tid & 31, sb = tid >> 5, d0 = db * 8, s0 = sb * 8;
      const f32x4 ga = *(const f32x4*)(lng + g * 256 + d0), gb = *(const f32x4*)(lng + g * 256 + d0 + 4), ba = *(const f32x4*)(lnb + g * 256 + d0), bb = *(const f32x4*)(lnb + g * 256 + d0 + 4);
      const float gl[8] = {ga.x, ga.y, ga.z, ga.w, gb.x, gb.y, gb.z, gb.w}, bl[8] = {ba.x, ba.y, ba.z, ba.w, bb.x, bb.y, bb.z, bb.w};
      float f[8][8];
#pragma unroll
      for (int i = 0; i < 8; ++i) { const v4u raw = *(const v4u*)(V + (size_t)(row0 + s0 + i) * 2048 + g * 256 + d0); const float mu = ST[2 * (s0 + i)], rs = ST[2 * (s0 + i) + 1];
#pragma unroll
          for (int k = 0; k < 4; ++k) { f[i][2 * k] = (bflo(raw[k]) - mu) * rs * gl[2 * k] + bl[2 * k]; f[i][2 * k + 1] = (bfhi(raw[k]) - mu) * rs * gl[2 * k + 1] + bl[2 * k + 1]; } }
#pragma unroll
      for (int dd = 0; dd < 8; ++dd) { v4u w; w.x = pk2(f[0][dd], f[1][dd]); w.y = pk2(f[2][dd], f[3][dd]); w.z = pk2(f[4][dd], f[5][dd]); w.w = pk2(f[6][dd], f[7][dd]);
          *(LAS v4u*)(lds + SG_VT + (d0 + dd) * SG_STRIDE + s0 * 2) = w; } }
    __syncthreads();
    f32x4 acc[2][8];
#pragma unroll
    for (int a = 0; a < 2; ++a)
#pragma unroll
        for (int b = 0; b < 8; ++b) acc[a][b] = (f32x4){0.f, 0.f, 0.f, 0.f};
    const int fr = lane & 15, fq = lane >> 4;
#pragma unroll
    for (int ks = 0; ks < 4; ++ks) { bf16x8 af[2];
#pragma unroll
        for (int a = 0; a < 2; ++a) af[a] = *(const LAS bf16x8*)(lds + SG_VT + (32 * wave + 16 * a + fr) * SG_STRIDE + (32 * ks + 8 * fq) * 2);
#pragma unroll
        for (int tb = SGU_TB0(ks); tb < 8; ++tb) { const bf16x8 bfr = *(const LAS bf16x8*)(lds + SG_W + (16 * tb + fr) * SG_STRIDE + (32 * ks + 8 * fq) * 2);
#pragma unroll
            for (int a = 0; a < 2; ++a) acc[a][tb] = __builtin_amdgcn_mfma_f32_16x16x32_bf16(af[a], bfr, acc[a][tb], 0, 0, 0); } }
    __syncthreads();
#pragma unroll
    for (int a = 0; a < 2; ++a)
#pragma unroll
        for (int tb = 0; tb < 8; ++tb) { v2u w; w.x = pk2(acc[a][tb][0], acc[a][tb][1]); w.y = pk2(acc[a][tb][2], acc[a][tb][3]);
            *(LAS v2u*)(lds + SG_VT + (16 * tb + fr) * SG_MSTRIDE + (32 * wave + 16 * a + 4 * fq) * 2) = w; }
    __syncthreads();
#pragma unroll
    for (int i = 0; i < 8; ++i) { const int c = tid + 512 * i, t = c >> 5, d8 = c & 31; const size_t off = (size_t)(row0 + t) * 2048 + g * 256 + d8 * 8;
        const v4u uu = *(const v4u*)(U + off), gg = *(const v4u*)(G + off), mm = *(const LAS v4u*)(lds + SG_VT + t * SG_MSTRIDE + d8 * 16); const float bs = sgub[g * 128 + t];
        v4u o;
#pragma unroll
        for (int k = 0; k < 4; ++k) o[k] = pk2(bflo(uu[k]) * (bflo(mm[k]) + bs) * bflo(gg[k]), bfhi(uu[k]) * (bfhi(mm[k]) + bs) * bfhi(gg[k]));
        *(v4u*)(U + off) = o; }
    __syncthreads();
}


#ifdef CHECK
#ifndef CHK_TOL
#define CHK_TOL 0.06f
#endif
constexpr size_t WS_CHK = 250 * MiB;
__device__ __forceinline__ unsigned hsh(unsigned x) { x ^= x >> 16; x *= 0x7feb352du; x ^= x >> 15; x *= 0x846ca68bu; x ^= x >> 16; return x; }
__device__ __forceinline__ float bfv(const bf16* p) { return __uint_as_float((unsigned)(*p) << 16); }
__device__ __forceinline__ float wdot(const bf16* a, const bf16* b, int n, int lane) { float s = 0.f;
    for (int k = lane * 8; k < n; k += 512) { const v4u x = *(const v4u*)(a + k), y = *(const v4u*)(b + k);
#pragma unroll
        for (int e = 0; e < 4; ++e) s += bflo(x[e]) * bflo(y[e]) + bfhi(x[e]) * bfhi(y[e]); }
    return wave_sum(s); }
__device__ __forceinline__ float wave_max(float v) { v = fmaxf(v, pg8::swz_xor<1>(v)); v = fmaxf(v, pg8::swz_xor<2>(v)); v = fmaxf(v, pg8::swz_xor<4>(v)); v = fmaxf(v, pg8::swz_xor<8>(v)); v = fmaxf(v, pg8::swz_xor<16>(v));
    auto rr = __builtin_amdgcn_permlane32_swap(__float_as_uint(v), __float_as_uint(v), false, false); return fmaxf(__uint_as_float(rr[0]), __uint_as_float(rr[1])); }
__device__ __forceinline__ void chk_put(unsigned* chk, int k, float got, float want, float tol_abs) { float e = fabsf(got - want) / (fabsf(want) + tol_abs); if (!(e == e)) e = 1e9f; e = wave_max(e); atomicMax(chk + k, __float_as_uint(e)); }
#define CHKPTR ((unsigned*)(GAS unsigned*)(ldp(PT, 18) + WS_CHK))
#endif
struct Args { const float* in[17]; const int* pos; float* out; unsigned char* ws; };
__global__ void __launch_bounds__(NWAVES * 64, 2) fwd_megakernel(Args args) {
    extern __shared__ __attribute__((aligned(16))) unsigned char lds[];
    cg::grid_group grid = cg::this_grid();
    Frame F; F.lds = (LAS unsigned char*)lds; F.tid = threadIdx.x; F.lane = F.tid & 63; F.wave = __builtin_amdgcn_readfirstlane(F.tid >> 6);
    F.G = gridDim.x; { const int bx = blockIdx.x; F.vcu = (F.G % 8 == 0) ? (bx % 8) * (F.G / 8) + bx / 8 : bx; }
    LAS unsigned long long* PT = (LAS unsigned long long*)(F.lds + 131072 + 1024);
    if (F.tid < 4) ((LAS unsigned*)(F.lds + 131072 + 512))[F.tid] = 0u;
    if (F.tid == 0) {
#define PTSET(k) PT[k] = (unsigned long long)args.in[k]
        PTSET(0); PTSET(1); PTSET(2); PTSET(3); PTSET(4); PTSET(5); PTSET(6); PTSET(7); PTSET(8); PTSET(9); PTSET(10); PTSET(11); PTSET(12); PTSET(13); PTSET(14); PTSET(15); PTSET(16);
#undef PTSET
        PT[17] = (unsigned long long)args.out; PT[18] = (unsigned long long)args.ws; }
    __syncthreads();
    int n_stamp = 0; (void)n_stamp;
    { XcdBarrier xb0 = xcd_barrier_post((unsigned*)(GAS unsigned*)(ldp(PT, 18) + WS_BAR), (volatile LAS unsigned*)(F.lds + 131072 + 512));
      if (F.tid == 0) ((volatile LAS unsigned*)(F.lds + 131072 + 512))[2] = xb0.x; }
#define GRID_SYNC_CG() do { asm volatile("s_waitcnt vmcnt(0) lgkmcnt(0)" ::: "memory"); grid.sync(); if (F.wave == 0) asm volatile("buffer_inv sc1\n\ts_waitcnt vmcnt(0)" ::: "memory"); __syncthreads(); STAMP(); } while (0)
#ifdef ALL_CG_SYNC
#define GRID_SYNC() GRID_SYNC_CG()
#else
#define GRID_SYNC() do { XcdBarrier xb_; xb_.st = (volatile LAS unsigned*)(F.lds + 131072 + 512); xb_.bar = (unsigned*)(GAS unsigned*)(ldp(PT, 18) + WS_BAR); xb_.x = (threadIdx.x == 0) ? xb_.st[2] : 0u; xcd_barrier(xb_); STAMP(); } while (0)
#endif
#ifdef TIMING
#define STAMP() do { if (blockIdx.x == 0 && threadIdx.x == 0) { ((unsigned long long*)((GAS unsigned char*)ldp(PT, 18) + 252 * MiB))[n_stamp] = __builtin_amdgcn_s_memrealtime(); } ++n_stamp; } while (0)
#else
#define STAMP() do { } while (0)
#endif
#define REFRESH() do { int t_ = threadIdx.x; asm volatile("" : "+v"(t_)); F.tid = t_; F.lane = t_ & 63; } while (0)
#define PIN(k) ((const float*)(const GAS float*)ldp(PT, k))
#define POUT ((float*)(GAS float*)ldp(PT, 17))
#define WSB(off) ((bf16*)(GAS bf16*)(ldp(PT, 18) + (off)))
#define WSF(off) ((float*)(GAS float*)(ldp(PT, 18) + (off)))
    const int gw = F.vcu * NWAVES + F.wave, NGW = F.G * NWAVES;
    LAS float* scr = (LAS float*)(F.lds + F.wave * 16384);

    STAMP();
    for (int rep_ = 0; rep_ < REP_P0; ++rep_) {
#ifndef SKIP_P0
    {
        REFRESH();
        const float *x = PIN(0), *pre_norm = PIN(2), *w_in = PIN(4), *w_out = PIN(5), *pool_w = PIN(6); const int* pos = (const int*)PIN(1); bf16 *Win_t = WSB(WS_WIN), *Wout_t = WSB(WS_WOUT), *Poolw_t = WSB(WS_POOLW), *XN = WSB(WS_XN); float* rope = WSF(WS_ROPE);
        constexpr int I_IN = (DMODEL / 64) * (INCOLS / 32), I_OUT = (DIN / 64) * (DMODEL / 32), I_PW = (256 / 64) * (256 / 32);
        for (int it = gw; it < I_IN + I_OUT + 4 * I_PW; it += NGW) { int r = it;
            if (r < I_IN) { p0_transpose_item(w_in, DMODEL, INCOLS, Win_t, 0, scr, r, F.lane); continue; } r -= I_IN;
            if (r < I_OUT) { p0_transpose_item(w_out, DIN, DMODEL, Wout_t, 0, scr, r, F.lane); continue; } r -= I_OUT;
            const int gq = r / I_PW; p0_transpose_item(pool_w + (size_t)gq * 65536, 256, 256, Poolw_t, gq * 256, scr, r % I_PW, F.lane); }
        for (int i = blockIdx.x * 512 + F.tid; i < M * 8; i += F.G * 512) { const int row = i >> 3, k = i & 7;
            const float inv = __powf(500000.0f, -(float)k * 0.125f); const float ang = (float)pos[row] * inv; float sn, cs; sincosf(ang, &sn, &cs);
            rope[(size_t)row * 16 + k] = cs; rope[(size_t)row * 16 + 8 + k] = sn; }
        for (int m = gw; m < M; m += NGW) rms_row_to_bf16(x + (size_t)m * DMODEL, pre_norm, XN + (size_t)m * DMODEL, F.lane);
#ifdef CHECK
        if (blockIdx.x == 0 && F.tid < 16) CHKPTR[F.tid] = (F.tid == 12) ? 0xffffu : 0u;
#endif
    }
#endif
    GRID_SYNC_CG();
    }
    for (int rep_ = 0; rep_ < REP_P1; ++rep_) {
#ifndef SKIP_P1
    {
        bf16 *XN = WSB(WS_XN), *Win_t = WSB(WS_WIN), *Abuf = WSB(WS_A), *G0 = (bf16*)POUT; float* rope = WSF(WS_ROPE);
        pg8::Gemm g{XN, Win_t, M, INCOLS, DMODEL, DMODEL, DMODEL, 0}; pg8::StaticOrder S; S.init(M, INCOLS, F.G, (int)blockIdx.x);
        pg8::EpiProj0 E{Abuf, G0, (size_t)(WS_Q - WS_A) / 2, rope, attn_body::C2};
        pg8::gemm_phase<pg8::EpiProj0, pg8::StaticOrder, PG_ALIGN, PG_SP2>(F.lds, g, S, E);
    }
#endif
    GRID_SYNC();
    }
#ifdef CHECK
    { REFRESH(); unsigned* chk = CHKPTR; bf16 *XN = WSB(WS_XN), *Win_t = WSB(WS_WIN), *Abuf = WSB(WS_A), *G0 = (bf16*)POUT; const float* rope = WSF(WS_ROPE);
      for (int i = gw; i < 4096; i += NGW) { const int row = hsh(i * 2 + 1) % M, c = (i < 64) ? (1024 + (i & 15) + 64 * (i >> 4)) : hsh(i * 2 + 2) % INCOLS; const int reg = c >> 10;
          const float p = wdot(XN + (size_t)row * 1024, Win_t + (size_t)c * 1024, 1024, F.lane); float want = p;
          if (reg == 1 || reg == 2) { const int d = c & 63; if (d < 16) { const int pc = d < 8 ? c + 8 : c - 8; const float p2 = wdot(XN + (size_t)row * 1024, Win_t + (size_t)pc * 1024, 1024, F.lane);
                  const float cs = rope[(size_t)row * 16 + (d & 7)], sn = rope[(size_t)row * 16 + 8 + (d & 7)]; want = d < 8 ? p * cs - p2 * sn : p * cs + p2 * sn; } if (reg == 1) want *= attn_body::C2; }
          if (reg >= 4) want = pg8::silu_f(p);
          const float got = reg < 4 ? bfv(Abuf + (size_t)reg * ((WS_Q - WS_A) / 2) + (size_t)row * 1024 + (c & 1023)) : bfv(G0 + (size_t)row * 2048 + (c - 4096));
          chk_put(chk, 0, got, want, 0.05f); } }
    GRID_SYNC();
#endif
#ifdef PROBE_ROPE
    { REFRESH(); bf16 *Qb = WSB(WS_Q), *Kb = WSB(WS_K); const float* rope = WSF(WS_ROPE);
      for (int idx = blockIdx.x * 512 + F.tid; idx < M * 32; idx += F.G * 512) { const int row = idx >> 5, hc = idx & 31; bf16* p = (hc < 16 ? Qb : Kb) + (size_t)row * 1024 + (hc & 15) * 64;
          v4u a = *(v4u*)p, b = *(v4u*)(p + 8); const float* rp = rope + (size_t)row * 16; float x1[8], x2[8];
#pragma unroll
          for (int k = 0; k < 4; ++k) { x1[2 * k] = bflo(a[k]); x1[2 * k + 1] = bfhi(a[k]); x2[2 * k] = bflo(b[k]); x2[2 * k + 1] = bfhi(b[k]); }
#pragma unroll
          for (int k = 0; k < 4; ++k) { const float c0 = rp[2 * k], s0 = rp[8 + 2 * k], c1 = rp[2 * k + 1], s1 = rp[8 + 2 * k + 1];
              a[k] = pk2(x1[2 * k] * c0 - x2[2 * k] * s0, x1[2 * k + 1] * c1 - x2[2 * k + 1] * s1); b[k] = pk2(x2[2 * k] * c0 + x1[2 * k] * s0, x2[2 * k + 1] * c1 + x1[2 * k + 1] * s1); }
          *(v4u*)p = a; *(v4u*)(p + 8) = b; } }
    GRID_SYNC();
#endif
    for (int rep_ = 0; rep_ < REP_P2; ++rep_) {
#ifndef SKIP_P2
    {
        bf16 *Qb = WSB(WS_Q), *Kb = WSB(WS_K), *Vb = WSB(WS_V), *Ob = WSB(WS_O);
        const attn_body::AttnTensors AT{(const attn_body::bf16*)Qb, (const attn_body::bf16*)Kb, (const attn_body::bf16*)Vb, (attn_body::bf16*)Ob};
        const attn_body::StaticOrder S((int)F.G, (int)blockIdx.x);
        attn_body::attn_phase<attn_body::StaticOrder, ATT_THRL>((char*)lds, AT, S);
    }
#endif
    GRID_SYNC();
    }
#ifdef CHECK
    { REFRESH(); unsigned* chk = CHKPTR; bf16 *Qb = WSB(WS_Q), *Kb = WSB(WS_K), *Vb = WSB(WS_V), *Ob = WSB(WS_O);
      for (int i = gw; i < 2048; i += NGW) { const unsigned hh = hsh(i * 3 + 7); const int b = hh & 3, vh = (hh >> 2) & 31; int row = (i < 256) ? i : (int)(hsh(i * 3 + 8) % SEQ); if (i >= 256 && i < 512) row = SEQ - 1 - (i - 256);
          const int qcol = (vh >> 2) * 128 + ((vh >> 1) & 1) * 64, vcol = (vh >> 2) * 128 + (vh & 1) * 64; const size_t rb = (size_t)b * SEQ;
          const bf16* qp = Qb + (rb + row) * 1024 + qcol; float m = -INFINITY;
          for (int k0 = 0; k0 <= row; k0 += 64) { const int k = k0 + F.lane; float s = -INFINITY; if (k <= row) { s = 0.f; const bf16* kp = Kb + (rb + k) * 1024 + qcol; for (int d = 0; d < 64; ++d) s += bfv(qp + d) * bfv(kp + d); } m = fmaxf(m, s); }
          m = wave_max(m); float l = 0.f, o = 0.f;
          for (int k0 = 0; k0 <= row; k0 += 64) { const int k = k0 + F.lane; float p = 0.f; if (k <= row) { float s = 0.f; const bf16* kp = Kb + (rb + k) * 1024 + qcol; for (int d = 0; d < 64; ++d) s += bfv(qp + d) * bfv(kp + d); p = __builtin_amdgcn_exp2f(s - m); }
              l += p; const int nk = (row - k0 + 1 < 64) ? row - k0 + 1 : 64; for (int j = 0; j < nk; ++j) { const float pj = __shfl(p, j); o += pj * bfv(Vb + (rb + k0 + j) * 1024 + vcol + F.lane); } }
          l = wave_sum(l); const float want = o / l, got = bfv(Ob + (rb + row) * 2048 + vh * 64 + F.lane);
          chk_put(chk, 1, got, want, 0.15f); } }
    GRID_SYNC();
#endif
    for (int rep_ = 0; rep_ < REP_P2b; ++rep_) {
#ifndef SKIP_P2b
    {
        REFRESH();
        const float *lq1 = PIN(8), *lk1 = PIN(9), *lq2 = PIN(10), *lk2 = PIN(11), *subln = PIN(12); bf16 *Abuf = WSB(WS_A), *XN = WSB(WS_XN), *Ob = WSB(WS_O), *Yb = WSB(WS_Y), *G0 = (bf16*)POUT;
        for (int task = blockIdx.x * 512 + F.tid; task < M * 128; task += F.G * 512) { const int row = task >> 7, ck = task & 127, gq = ck >> 5, w = 2 << gq, s = row & (SEQ - 1), cnt = (s + 1 < w) ? s + 1 : w;
            float sum[8], a0[8];
#pragma unroll
            for (int k = 0; k < 8; ++k) sum[k] = 0.f;
            for (int j = 0; j < cnt; ++j) { const v4u r = *(const v4u*)(Abuf + (size_t)(row - j) * 1024 + ck * 8);
#pragma unroll
                for (int k = 0; k < 4; ++k) { const float lo = bflo(r[k]), hi = bfhi(r[k]); sum[2 * k] += lo; sum[2 * k + 1] += hi; if (j == 0) { a0[2 * k] = lo; a0[2 * k + 1] = hi; } } }
            const float rc = 1.f / (float)cnt; v4u o;
#pragma unroll
            for (int k = 0; k < 4; ++k) o[k] = pk2(sum[2 * k] * rc - a0[2 * k], sum[2 * k + 1] * rc - a0[2 * k + 1]);
            *(v4u*)(XN + (size_t)row * 1024 + ck * 8) = o; }
        float lam; { const float a = wave_sum(lq1[F.lane] * lk1[F.lane]), b = wave_sum(lq2[F.lane] * lk2[F.lane]); lam = expf(a) - expf(b) + 0.2f; }
        for (int m = gw; m < M; m += NGW) combine_row(Ob, G0, subln, Yb, m, lam, F.lane);
    }
#endif
    GRID_SYNC();
    }
    for (int rep_ = 0; rep_ < REP_P2c; ++rep_) {
#ifndef SKIP_P2c
    {
        const float* pool_scale = PIN(7); bf16 *XN = WSB(WS_XN), *Poolw_t = WSB(WS_POOLW), *Yb = WSB(WS_Y), *G0 = (bf16*)POUT;
        pg8::Gemm g{XN, Poolw_t, M, 1024, 256, 1024, 256, 512}; pg8::StaticOrder S; S.init(M, 1024, F.G, (int)blockIdx.x);
        pg8::EpiPool E{Yb, G0, pool_scale};
        pg8::gemm_phase<pg8::EpiPool, pg8::StaticOrder, PG_ALIGN, PG_SP2>(F.lds, g, S, E);
    }
#endif
    GRID_SYNC();
    }
#ifdef CHECK
    { REFRESH(); unsigned* chk = CHKPTR; const float *lq1 = PIN(8), *lk1 = PIN(9), *lq2 = PIN(10), *lk2 = PIN(11), *subln = PIN(12), *pool_scale = PIN(7); bf16 *Abuf = WSB(WS_A), *XN = WSB(WS_XN), *Ob = WSB(WS_O), *Yb = WSB(WS_Y), *G0 = (bf16*)POUT, *Poolw_t = WSB(WS_POOLW);
      float lam; { const float a = wave_sum(lq1[F.lane] * lk1[F.lane]), b = wave_sum(lq2[F.lane] * lk2[F.lane]); lam = expf(a) - expf(b) + 0.2f; }
      for (int i = gw; i < 4096; i += NGW) { const int row = (i < 512) ? ((i & 127) + (i >> 7) * SEQ) : (int)(hsh(i * 5 + 1) % M); const int col = (hsh(i * 5 + 2) % 16) * 64 + F.lane, g = col >> 8, w = 2 << g, s = row & (SEQ - 1), cnt = (s + 1 < w) ? s + 1 : w;
          float sum = 0.f; for (int j = 0; j < cnt; ++j) sum += bfv(Abuf + (size_t)(row - j) * 1024 + col); const float want = sum / (float)cnt - bfv(Abuf + (size_t)row * 1024 + col);
          chk_put(chk, 2, bfv(XN + (size_t)row * 1024 + col), want, 0.05f);
          const int h = hsh(i * 5 + 3) & 7; float o0 = bfv(Ob + (size_t)row * 2048 + h * 256 + F.lane) - lam * bfv(Ob + (size_t)row * 2048 + h * 256 + 128 + F.lane), o1 = bfv(Ob + (size_t)row * 2048 + h * 256 + 64 + F.lane) - lam * bfv(Ob + (size_t)row * 2048 + h * 256 + 192 + F.lane);
          const float ss = wave_sum(o0 * o0 + o1 * o1), rs = 0.8f / sqrtf(ss / 128.f + 1e-5f);
          chk_put(chk, 3, bfv(Yb + (size_t)row * 2048 + 1024 + h * 128 + F.lane), o0 * rs * subln[F.lane] * bfv(G0 + (size_t)row * 2048 + 1024 + h * 128 + F.lane), 0.03f);
          chk_put(chk, 3, bfv(Yb + (size_t)row * 2048 + 1024 + h * 128 + 64 + F.lane), o1 * rs * subln[64 + F.lane] * bfv(G0 + (size_t)row * 2048 + 1024 + h * 128 + 64 + F.lane), 0.03f);
          const int c2 = hsh(i * 5 + 4) % 1024, g2 = c2 >> 8; const float yp = wdot(XN + (size_t)row * 1024 + g2 * 256, Poolw_t + (size_t)c2 * 256, 256, F.lane) * pool_scale[c2] * bfv(G0 + (size_t)row * 2048 + c2);
          chk_put(chk, 4, bfv(Yb + (size_t)row * 2048 + c2), yp, 0.05f); } }
    GRID_SYNC();
#endif
    for (int rep_ = 0; rep_ < REP_P3; ++rep_) {
#ifndef SKIP_P3
    {
        bf16 *Yb = WSB(WS_Y), *Wout_t = WSB(WS_WOUT); float* out0 = WSF(WS_OUT0);
        pg8::Gemm g{Yb, Wout_t, M, DMODEL, DIN, DIN, DIN, 0}; pg8::StaticOrder S; S.init(M, DMODEL, F.G, (int)blockIdx.x);
        pg8::EpiF32 E{out0, DMODEL};
        pg8::gemm_phase<pg8::EpiF32, pg8::StaticOrder, PG_ALIGN, PG_SP2>(F.lds, g, S, E);
    }
#endif
    GRID_SYNC();
    }
#ifdef CHECK
    { REFRESH(); unsigned* chk = CHKPTR; bf16 *Yb = WSB(WS_Y), *Wout_t = WSB(WS_WOUT); float* out0 = WSF(WS_OUT0);
      for (int i = gw; i < 4096; i += NGW) { const int row = hsh(i * 7 + 1) % M, col = hsh(i * 7 + 2) % 1024;
          chk_put(chk, 5, out0[(size_t)row * 1024 + col], wdot(Yb + (size_t)row * 2048, Wout_t + (size_t)col * 2048, 2048, F.lane), 0.05f); } }
    GRID_SYNC();
#endif
    for (int rep_ = 0; rep_ < REP_P3b; ++rep_) {
#ifndef SKIP_P3b
    {
        REFRESH();
        const float *x = PIN(0), *pre_norm = PIN(2), *post_norm = PIN(3), *w_in = PIN(4), *w_out = PIN(5), *sgu_w = PIN(15); float *out = POUT, *out0 = WSF(WS_OUT0); bf16 *Win_t = WSB(WS_WIN), *Wout_t = WSB(WS_WOUT), *Poolw_t = WSB(WS_POOLW), *Abuf = WSB(WS_A);
        constexpr int I_IN = (DMODEL / 64) * (INCOLS / 32), I_OUT = (DIN / 64) * (DMODEL / 32);
        for (int it = gw; it < I_IN + I_OUT; it += NGW) { int r = it;
            if (r < I_IN) { p0_transpose_item(w_in + (size_t)DMODEL * INCOLS, DMODEL, INCOLS, Win_t, 0, scr, r, F.lane); continue; } r -= I_IN;
            p0_transpose_item(w_out + (size_t)DIN * DMODEL, DIN, DMODEL, Wout_t, 0, scr, r, F.lane); }
        for (int i = blockIdx.x * 512 + F.tid; i < 8 * 128 * 128; i += F.G * 512) { const int s = i & 127, t = (i >> 7) & 127; Poolw_t[i] = (bf16)((s <= t) ? f2bf(sgu_w[i]) : 0u); }
        for (int m = gw; m < M; m += NGW) post_row<true>(out0 + (size_t)m * DMODEL, x + (size_t)m * DMODEL, post_norm, out + (size_t)m * DMODEL, pre_norm + DMODEL, Abuf + (size_t)m * DMODEL, F.lane);
    }
#endif
    GRID_SYNC();
    }
    for (int rep_ = 0; rep_ < REP_P4; ++rep_) {
#ifndef SKIP_P4
    {
        bf16 *Abuf = WSB(WS_A), *Win_t = WSB(WS_WIN), *Ub = WSB(WS_U); float* stats = WSF(WS_STATS);
        pg8::Gemm g{Abuf, Win_t, M, INCOLS, DMODEL, DMODEL, DMODEL, 0}; pg8::StaticOrder S; S.init(M, INCOLS, F.G, (int)blockIdx.x);
        pg8::EpiProj1 E{Ub, (size_t)(WS_V1 - WS_U) / 2, stats};
        pg8::gemm_phase<pg8::EpiProj1, pg8::StaticOrder, PG_ALIGN, PG_SP2>(F.lds, g, S, E);
    }
#endif
    GRID_SYNC();
    }
#ifdef CHECK
    { REFRESH(); unsigned* chk = CHKPTR; bf16 *Abuf = WSB(WS_A), *Win_t = WSB(WS_WIN), *Ub = WSB(WS_U), *V1b = WSB(WS_V1); float* stats = WSF(WS_STATS);
      for (int i = gw; i < 4096; i += NGW) { const int row = hsh(i * 11 + 1) % M, c = hsh(i * 11 + 2) % INCOLS, reg = c >> 11;
          const float p = wdot(Abuf + (size_t)row * 1024, Win_t + (size_t)c * 1024, 1024, F.lane); const float want = reg < 2 ? pg8::gelu_tanh_f(p) : pg8::silu_f(p);
          chk_put(chk, 6, bfv(Ub + (size_t)reg * ((WS_V1 - WS_U) / 2) + (size_t)row * 2048 + (c & 2047)), want, 0.05f);
          float s = 0.f, q = 0.f; for (int k = F.lane; k < 2048; k += 64) { const float v = bfv(V1b + (size_t)row * 2048 + k); s += v; q += v * v; } s = wave_sum(s); q = wave_sum(q);
          float s2 = 0.f, q2 = 0.f; if (F.lane < 32) { s2 = stats[(size_t)row * 64 + 2 * F.lane]; q2 = stats[(size_t)row * 64 + 2 * F.lane + 1]; } s2 = wave_sum(s2); q2 = wave_sum(q2);
          chk_put(chk, 7, s + 50.f * (s2 - s), s, 1.0f); chk_put(chk, 7, q + 50.f * (q2 - q), q, 1.0f); } }
    GRID_SYNC();
#endif
#ifndef SKIP_P5
    { REFRESH(); const float *ln_g = PIN(13), *ln_b = PIN(14), *sgu_b = PIN(16); bf16 *Ub = WSB(WS_U), *V1b = WSB(WS_V1), *G1b = WSB(WS_G1), *Poolw_t = WSB(WS_POOLW); float* stats = WSF(WS_STATS);
    for (int un = F.vcu; un < 128 * 8; un += F.G) sgu_unit(F, un >> 3, un & 7, Ub, V1b, G1b, stats, Poolw_t, ln_g, ln_b, sgu_b); }
#endif
    GRID_SYNC();
#ifdef CHECK
    { REFRESH(); unsigned* chk = CHKPTR; const float *ln_g = PIN(13), *ln_b = PIN(14), *sgu_b = PIN(16); bf16 *Abuf = WSB(WS_A), *Win_t = WSB(WS_WIN), *Ub = WSB(WS_U), *V1b = WSB(WS_V1), *G1b = WSB(WS_G1), *Wm = WSB(WS_POOLW);
      for (int i = gw; i < 2048; i += NGW) { const int row = (i < 256) ? (i & 127) * 129 % M : (int)(hsh(i * 13 + 1) % M), ch = hsh(i * 13 + 2) % 2048, t = row & 127, r0 = row - t, g = ch >> 8; float mixed = 0.f;
          for (int s = 0; s <= t; ++s) { float a = 0.f, q = 0.f; for (int k = F.lane; k < 2048; k += 64) { const float v = bfv(V1b + (size_t)(r0 + s) * 2048 + k); a += v; q += v * v; } a = wave_sum(a); q = wave_sum(q);
              const float mu = a / 2048.f, var = q / 2048.f - mu * mu, rs = 1.f / sqrtf(var + 1e-6f); const float vn = (bfv(V1b + (size_t)(r0 + s) * 2048 + ch) - mu) * rs * ln_g[ch] + ln_b[ch];
              mixed += bfv(Wm + (size_t)(g * 128 + t) * 128 + s) * vn; }
          mixed += sgu_b[g * 128 + t]; const float u = pg8::gelu_tanh_f(wdot(Abuf + (size_t)row * 1024, Win_t + (size_t)ch * 1024, 1024, F.lane));
          { const float got = bfv(Ub + (size_t)row * 2048 + ch), want = u * mixed * bfv(G1b + (size_t)row * 2048 + ch); chk_put(chk, 8, got, want, 0.05f);
            if (fabsf(got - want) / (fabsf(want) + 0.05f) > CHK_TOL) { atomicMin(chk + 12, (unsigned)((t << 3) | g)); atomicAdd(chk + 13, 1u); } } } }
    GRID_SYNC();
#endif
    for (int rep_ = 0; rep_ < REP_P6; ++rep_) {
#ifndef SKIP_P6
    {
        bf16 *Ub = WSB(WS_U), *Wout_t = WSB(WS_WOUT); float* out1 = WSF(WS_OUT1);
        pg8::Gemm g{Ub, Wout_t, M, DMODEL, DIN, DIN, DIN, 0}; pg8::StaticOrder S; S.init(M, DMODEL, F.G, (int)blockIdx.x);
        pg8::EpiF32 E{out1, DMODEL};
        pg8::gemm_phase<pg8::EpiF32, pg8::StaticOrder, PG_ALIGN, PG_SP2>(F.lds, g, S, E);
    }
#endif
    GRID_SYNC();
    }
#ifdef CHECK
    { REFRESH(); unsigned* chk = CHKPTR; bf16 *Ub = WSB(WS_U), *Wout_t = WSB(WS_WOUT); float* out1 = WSF(WS_OUT1);
      for (int i = gw; i < 4096; i += NGW) { const int row = hsh(i * 17 + 1) % M, col = hsh(i * 17 + 2) % 1024;
          chk_put(chk, 9, out1[(size_t)row * 1024 + col], wdot(Ub + (size_t)row * 2048, Wout_t + (size_t)col * 2048, 2048, F.lane), 0.05f); } }
    GRID_SYNC();
#endif
    for (int rep_ = 0; rep_ < EXTRA_SYNCS; ++rep_) GRID_SYNC();
#ifndef SKIP_P7
    { REFRESH(); const float* post_norm = PIN(3); float *out = POUT, *out1 = WSF(WS_OUT1);
    for (int m = gw; m < M; m += NGW) post_row<false>(out1 + (size_t)m * DMODEL, out + (size_t)m * DMODEL, post_norm + DMODEL, out + (size_t)m * DMODEL, nullptr, nullptr, F.lane); }
#endif
#ifdef TIMING
    STAMP();
    if (blockIdx.x == 0 && threadIdx.x == 0) { const unsigned long long* ts = (const unsigned long long*)((GAS unsigned char*)ldp(PT, 18) + 252 * MiB);
        const float dA = (float)(ts[TSEL_A + 1] - ts[TSEL_A]) * 0.01f, dN = (float)(ts[TSEL_N + 1] - ts[TSEL_N]) * 0.01f;
        int N = (int)(dN / TSEL_NDIV + 0.5f); N = N < 1 ? 1 : (N > 99 ? 99 : N); const float A = dA * 1024.f; float* o = POUT; for (int n = 0; n < N; ++n) o[n] = A; }
#endif
#ifdef CHECK
    GRID_SYNC();
    if (blockIdx.x == 0 && F.tid == 0) { int kmin = -1; for (int k = 9; k >= 0; --k) if (__uint_as_float(CHKPTR[k]) > CHK_TOL) kmin = k; if (kmin >= 0) POUT[0] = (float)(1u << (25 - kmin));
#ifdef CHK_SGU_CODE
        { const unsigned code = CHK_SGU_CODE ? CHKPTR[13] : CHKPTR[12]; if (code != 0xffffu) { const float A = (float)(1u << (10 + (code >> 6))); const int N = (code & 63) + 1; for (int n = 0; n < N; ++n) POUT[n] = A; } }
#endif
    }
#endif
}

extern "C" void kernel_launch(void* const* d_in, const int* in_sizes, int n_in, void* d_out, int out_size, void* d_ws, size_t ws_size, hipStream_t stream) {
    static int grid = 0;
    if (grid == 0) {
        if (n_in != 17 || in_sizes[0] != M * DMODEL || out_size != M * DMODEL || ws_size < WS_END) { fprintf(stderr, "kernel_launch: unexpected shapes (n_in %d, ws %zu)\n", n_in, ws_size); grid = -1; return; }
        int dev = 0, cus = 0, per_cu = 0;
        hipGetDevice(&dev); hipDeviceGetAttribute(&cus, hipDeviceAttributeMultiprocessorCount, dev);
        if (hipFuncSetAttribute((const void*)fwd_megakernel, hipFuncAttributeMaxDynamicSharedMemorySize, LDS_BYTES) != hipSuccess) { fprintf(stderr, "kernel_launch: hipFuncSetAttribute failed\n"); grid = -1; return; }
        if (hipOccupancyMaxActiveBlocksPerMultiprocessor(&per_cu, (const void*)fwd_megakernel, NWAVES * 64, LDS_BYTES) != hipSuccess || per_cu < 1) { fprintf(stderr, "kernel_launch: occupancy query says %d\n", per_cu); per_cu = 1; }
        (void)hipGetLastError();
        grid = cus * 1;
    }
    if (grid < 0) return;
    if (hipMemsetAsync(d_ws, 0, 65536, stream) != hipSuccess) { fprintf(stderr, "kernel_launch: memset of the barrier words failed\n"); return; }
    Args a{};
    for (int i = 0; i < 17; ++i) a.in[i] = (const float*)d_in[i];
    a.pos = (const int*)d_in[1]; a.out = (float*)d_out; a.ws = (unsigned char*)d_ws;
    void* kargs[] = {&a};
    hipError_t e = hipLaunchCooperativeKernel((const void*)fwd_megakernel, dim3(grid), dim3(NWAVES * 64), kargs, LDS_BYTES, stream);
    if (e != hipSuccess) fprintf(stderr, "cooperative launch failed: %s (grid %d)\n", hipGetErrorString(e), grid);
}
```

```cpp
#include <hip/hip_runtime.h>
#include <hip/hip_cooperative_groups.h>
#include <cstdio>
#include <cstdint>

namespace pg8 {
#define PG8_LAS __attribute__((address_space(3)))
typedef unsigned short bf16_t;
typedef short bf16x8 __attribute__((ext_vector_type(8)));
typedef float f32x4 __attribute__((ext_vector_type(4)));
typedef unsigned u32x4 __attribute__((ext_vector_type(4)));
constexpr int BM = 256, BK = 64, HALF = 128, HTB = HALF * BK * 2  , STAGE_BYTES = 8 * HTB, NXCD = 8, WGM = 8;

__host__ __device__ __forceinline__ int lds_byte(int r, int c) { const int st = (r >> 4) * 2 + (c >> 5), rr = r & 15, cc = c & 31, ob = rr * 64 + cc * 2; return st * 1024 + (ob ^ (((ob >> 9) & 1) << 5)); }
__host__ __device__ __forceinline__ void stage_rc(int b, int& R, int& C) { const int st = b / 1024, sb = b % 1024, swz = sb ^ (((sb >> 9) & 1) << 5); R = (st >> 1) * 16 + swz / 64; C = (st & 1) * 32 + (swz % 64) / 2; }
__host__ __device__ __forceinline__ int perm32(int rho) { const int n = rho >> 4, i = rho & 15; return 8 * (i >> 2) + 4 * n + (i & 3); }

struct Unit { int pm, pn; };
struct Gemm { const bf16_t* A; const bf16_t* Bt; int M, N, K, lda, ldb, a_pn_bytes; };

struct StaticOrder {
    int nM, nN, nwg, G, c;
    __host__ __device__ void init(int M, int N, int G_, int c_) { nM = M / BM; nN = N / BM; nwg = nM * nN; G = G_; c = c_; }
    __host__ __device__ bool next(int i, Unit& u) const {
        const long L = (long)i * G + c; if (L >= nwg) return false;
        int wgid = (int)L; { const int q = nwg / NXCD, r = nwg % NXCD, xcd = wgid % NXCD, off = wgid / NXCD; wgid = (xcd < r ? xcd * (q + 1) : r * (q + 1) + (xcd - r) * q) + off; }
        const int nig = WGM * nN, gid = wgid / nig, fm = gid * WGM, gsz = (nM - fm) < WGM ? (nM - fm) : WGM;
        u.pm = fm + ((wgid % nig) % gsz); u.pn = (wgid % nig) / gsz; return true;
    }
    __device__ __forceinline__ void a_ready(const Unit&) const {}
    __device__ __forceinline__ void done(const Unit&) const {}
};

typedef float f32x2c_t __attribute__((ext_vector_type(2))); typedef __bf16 bf16x2c_t __attribute__((ext_vector_type(2)));
__device__ __forceinline__ unsigned cvt_pk_bf16(float lo, float hi) { const f32x2c_t v = {lo, hi}; const bf16x2c_t b = __builtin_convertvector(v, bf16x2c_t); return __builtin_bit_cast(unsigned, b); }
__device__ __forceinline__ float silu_f(float x) { return x * __builtin_amdgcn_rcpf(1.0f + __builtin_amdgcn_exp2f(-1.4426950408889634f * x)); }
__device__ __forceinline__ float gelu_tanh_f(float x) { const float z = 0.7978845608028654f * (x + 0.044715f * x * x * x); return x * __builtin_amdgcn_rcpf(1.0f + __builtin_amdgcn_exp2f(-2.8853900817779268f * z)); }
__device__ __forceinline__ u32x4 pack8(const f32x4& v0, const f32x4& v1) { u32x4 w; w.x = cvt_pk_bf16(v0[0], v0[1]); w.y = cvt_pk_bf16(v0[2], v0[3]); w.z = cvt_pk_bf16(v1[0], v1[1]); w.w = cvt_pk_bf16(v1[2], v1[3]); return w; }
template <int X> __device__ __forceinline__ float swz_xor(float v) { return __int_as_float(__builtin_amdgcn_ds_swizzle(__float_as_int(v), (X << 10) | 0x1F)); }
__device__ __forceinline__ float half_sum(float v) { auto rr = __builtin_amdgcn_permlane32_swap(__float_as_uint(v), __float_as_uint(v), false, false); return __uint_as_float(rr[0]) + __uint_as_float(rr[1]); }
__device__ __forceinline__ f32x4 shx16(const f32x4& v) { f32x4 r; r[0] = swz_xor<16>(v[0]); r[1] = swz_xor<16>(v[1]); r[2] = swz_xor<16>(v[2]); r[3] = swz_xor<16>(v[3]); return r; }

struct EpiProj0 {
    static constexpr bool PERM = true, AFTER_DRAIN = false;
    bf16_t *A, *G; size_t rstride; const float* rope; float qscale;
    __device__ __forceinline__ void operator()(const f32x4 (&acc)[2][2][4][2], const Unit& u, int wr, int wc, int fr, int fq) const {
        const int row0 = u.pm * BM + wr * 64 + fr, pn = u.pn, reg = pn >> 2;
        bf16_t* base; int ldc, colt;
        if (reg < 4) { base = A + (size_t)reg * rstride; ldc = 1024; colt = (pn & 3) * 256; } else { base = G; ldc = 2048; colt = (pn - 16) * 256; }
        const int col0 = colt + wc * 32 + 8 * fq;

#ifdef PROBE_ROPE
        const bool rot_tile = false,
#else
        const bool rot_tile = (reg == 1 || reg == 2),
#endif
        rot_lane = ((wc & 1) == 0) && (fq < 2), gate = reg >= 4;
        const float sc = (reg == 1) ? qscale : 1.f, sgn = (fq == 0) ? -1.f : 1.f;
#pragma unroll
        for (int ai = 0; ai < 2; ++ai)
#pragma unroll
            for (int m = 0; m < 4; ++m) { const int row = row0 + ai * HALF + m * 16; bf16_t* rowp = base + (size_t)row * ldc + col0;
                f32x4 c0 = {1.f, 1.f, 1.f, 1.f}, c1 = c0, s0 = {0.f, 0.f, 0.f, 0.f}, s1 = s0;
                if (rot_tile) { const f32x4* rp = (const f32x4*)(rope + (size_t)row * 16); c0 = rp[0]; c1 = rp[1]; s0 = rp[2]; s1 = rp[3]; }
#pragma unroll
                for (int bj = 0; bj < 2; ++bj) { f32x4 v0 = acc[ai][bj][m][0], v1 = acc[ai][bj][m][1];
                    if (rot_tile) { const f32x4 p0 = shx16(v0), p1 = shx16(v1); const f32x4 r0 = v0 * c0 + (p0 * s0) * sgn, r1 = v1 * c1 + (p1 * s1) * sgn; if (rot_lane) { v0 = r0; v1 = r1; } }
                    if (gate) {
#pragma unroll
                        for (int j = 0; j < 4; ++j) { v0[j] = silu_f(v0[j]); v1[j] = silu_f(v1[j]); } }
                    v0 = v0 * sc; v1 = v1 * sc;
                    *(u32x4*)(rowp + bj * HALF) = pack8(v0, v1); } }
    }
};
struct EpiProj1 {
    static constexpr bool PERM = true, AFTER_DRAIN = false;
    bf16_t *U; size_t rstride; float* stats;
    __device__ __forceinline__ void operator()(const f32x4 (&acc)[2][2][4][2], const Unit& u, int wr, int wc, int fr, int fq) const {
        const int row0 = u.pm * BM + wr * 64 + fr, pn = u.pn, reg = pn >> 3;
        bf16_t* base = U + (size_t)reg * rstride; const int col0 = (pn & 7) * 256 + wc * 32 + 8 * fq;
#pragma unroll
        for (int ai = 0; ai < 2; ++ai)
#pragma unroll
            for (int m = 0; m < 4; ++m) { const int row = row0 + ai * HALF + m * 16; bf16_t* rowp = base + (size_t)row * 2048 + col0; float s = 0.f, q = 0.f;
#pragma unroll
                for (int bj = 0; bj < 2; ++bj) { f32x4 v0 = acc[ai][bj][m][0], v1 = acc[ai][bj][m][1];
#pragma unroll
                    for (int j = 0; j < 4; ++j) { if (reg == 2) { v0[j] = silu_f(v0[j]); v1[j] = silu_f(v1[j]); } else { v0[j] = gelu_tanh_f(v0[j]); v1[j] = gelu_tanh_f(v1[j]); } }
                    if (reg == 1) {
#pragma unroll
                        for (int j = 0; j < 4; ++j) { s += v0[j] + v1[j]; q += v0[j] * v0[j] + v1[j] * v1[j]; } }
                    *(u32x4*)(rowp + bj * HALF) = pack8(v0, v1); }
                if (reg == 1) { s += swz_xor<16>(s); s = half_sum(s); q += swz_xor<16>(q); q = half_sum(q);
                    if (fq == 0) { float* sp = stats + ((size_t)row * 32 + (pn - 8) * 4 + wc) * 2; sp[0] = s; sp[1] = q; } } }
    }
};
struct EpiF32 {
    static constexpr bool PERM = true, AFTER_DRAIN = false;
    float* O; int ldc;
    __device__ __forceinline__ void operator()(const f32x4 (&acc)[2][2][4][2], const Unit& u, int wr, int wc, int fr, int fq) const {
        const int row0 = u.pm * BM + wr * 64 + fr, col0 = u.pn * BM + wc * 32 + 8 * fq;
#pragma unroll
        for (int ai = 0; ai < 2; ++ai)
#pragma unroll
            for (int m = 0; m < 4; ++m) { float* rowp = O + (size_t)(row0 + ai * HALF + m * 16) * ldc + col0;
#pragma unroll
                for (int bj = 0; bj < 2; ++bj) { *(f32x4*)(rowp + bj * HALF) = acc[ai][bj][m][0]; *(f32x4*)(rowp + bj * HALF + 4) = acc[ai][bj][m][1]; } }
    }
};
struct EpiPool {
    static constexpr bool PERM = true, AFTER_DRAIN = false;
    bf16_t* Y; const bf16_t* G; const float* scale;
    __device__ __forceinline__ void operator()(const f32x4 (&acc)[2][2][4][2], const Unit& u, int wr, int wc, int fr, int fq) const {
        const int row0 = u.pm * BM + wr * 64 + fr, col0 = u.pn * BM + wc * 32 + 8 * fq;
        f32x4 sv[2][2];
#pragma unroll
        for (int bj = 0; bj < 2; ++bj) { sv[bj][0] = *(const f32x4*)(scale + col0 + bj * HALF); sv[bj][1] = *(const f32x4*)(scale + col0 + bj * HALF + 4); }
#pragma unroll
        for (int ai = 0; ai < 2; ++ai)
#pragma unroll
            for (int m = 0; m < 4; ++m) { const size_t off = (size_t)(row0 + ai * HALF + m * 16) * 2048 + col0;
#pragma unroll
                for (int bj = 0; bj < 2; ++bj) { const u32x4 gw = *(const u32x4*)(G + off + bj * HALF);
                    f32x4 g0, g1; g0[0] = __uint_as_float(gw.x << 16); g0[1] = __uint_as_float(gw.x & 0xffff0000u); g0[2] = __uint_as_float(gw.y << 16); g0[3] = __uint_as_float(gw.y & 0xffff0000u);
                    g1[0] = __uint_as_float(gw.z << 16); g1[1] = __uint_as_float(gw.z & 0xffff0000u); g1[2] = __uint_as_float(gw.w << 16); g1[3] = __uint_as_float(gw.w & 0xffff0000u);
                    const f32x4 v0 = acc[ai][bj][m][0] * sv[bj][0] * g0, v1 = acc[ai][bj][m][1] * sv[bj][1] * g1;
                    *(u32x4*)(Y + off + bj * HALF) = pack8(v0, v1); } }
    }
};

template <class Epi, class Sched, bool ALIGN_EPI = false, bool SP2 = false>
__device__ __forceinline__ void gemm_phase(PG8_LAS unsigned char* lds, const Gemm g, const Sched& S, const Epi& E) {
    int tid_ = threadIdx.x; asm volatile("" : "+v"(tid_));
    const int tid = tid_, wid = __builtin_amdgcn_readfirstlane(tid >> 6), lane = tid & 63, wr = wid >> 2, wc = wid & 3, fr = lane & 15, fq = lane >> 4;
    const int K = g.K, nt = K / BK;
    unsigned voffA[2], voffB[2];
#pragma unroll
    for (int i = 0; i < 2; ++i) { int R, C; stage_rc(tid * 16 + i * 8192, R, C); const int Rb = Epi::PERM ? ((R & ~31) + perm32(R & 31)) : R;
        voffA[i] = (unsigned)(R * g.lda + C) * 2u; voffB[i] = (unsigned)(Rb * g.ldb + C) * 2u; }
    const size_t kstep = (size_t)(BK * 2);
    const size_t hstepA = (size_t)HALF * g.lda * 2, hstepB = (size_t)HALF * g.ldb * 2;
    const size_t tstepA = 2 * hstepA, tstepB = 2 * hstepB, apn = (size_t)g.a_pn_bytes;
    const unsigned ldsw = (unsigned)wid * 1024u;
    const int aoff = lds_byte(wr * 64 + fr, fq * 8), boff = lds_byte(wc * 32 + fr, fq * 8);
#define PG8_SA(b, h) (((b) * 2 + (h)) * HTB)
#define PG8_SB(b, h) ((4 + (b) * 2 + (h)) * HTB)
#define PG8_STAGE(bufoff, gbase, voff) do { _Pragma("unroll") for (int _i = 0; _i < 2; ++_i) \
        __builtin_amdgcn_global_load_lds((const unsigned*)((const char*)(gbase) + (voff)[_i]), (PG8_LAS unsigned*)(lds + (bufoff) + ldsw + _i * 8192), 16, 0, 0); } while (0)
#define PG8_LDA(dst, b, h) do { _Pragma("unroll") for (int m = 0; m < 4; ++m) _Pragma("unroll") for (int k = 0; k < 2; ++k) dst[m][k] = *(const PG8_LAS bf16x8*)(lds + PG8_SA(b, h) + aoff + m * 2048 + k * 1024); } while (0)
#define PG8_LDB(dst, b, h) do { _Pragma("unroll") for (int n = 0; n < 2; ++n) _Pragma("unroll") for (int k = 0; k < 2; ++k) dst[n][k] = *(const PG8_LAS bf16x8*)(lds + PG8_SB(b, h) + boff + n * 2048 + k * 1024); } while (0)
#define PG8_MMA(ai, bj, At, Bt) do { __builtin_amdgcn_s_setprio(1); _Pragma("unroll") for (int m = 0; m < 4; ++m) _Pragma("unroll") for (int n = 0; n < 2; ++n) _Pragma("unroll") for (int k = 0; k < 2; ++k) \
        acc[ai][bj][m][n] = __builtin_amdgcn_mfma_f32_16x16x32_bf16(Bt[n][k], At[m][k], acc[ai][bj][m][n], 0, 0, 0); __builtin_amdgcn_s_setprio(0); } while (0)
#define PG8_WAIT_V(n) asm volatile("s_waitcnt vmcnt(" #n ")" ::: "memory")
#define PG8_WAIT_L(n) asm volatile("s_waitcnt lgkmcnt(" #n ")" ::: "memory")
#define PG8_BAR __builtin_amdgcn_s_barrier()
#define PG8_SCHED __builtin_amdgcn_sched_barrier(0)
    Unit cur, nxt; int ui = 0;
    if (!S.next(0, cur)) return;
    f32x4 acc[2][2][4][2];
#pragma unroll
    for (int a = 0; a < 2; ++a)
#pragma unroll
        for (int b = 0; b < 2; ++b)
#pragma unroll
            for (int m = 0; m < 4; ++m)
#pragma unroll
                for (int n = 0; n < 2; ++n) acc[a][b][m][n] = (f32x4){0.f, 0.f, 0.f, 0.f};
    bf16x8 At[4][2], B0[2][2], B1[2][2];
    const char* cA = (const char*)g.A + (size_t)cur.pm * tstepA + (size_t)cur.pn * apn; const char* cB = (const char*)g.Bt + (size_t)cur.pn * tstepB;
    S.a_ready(cur);
    if constexpr (SP2) {
        PG8_STAGE(PG8_SB(0, 0), cB, voffB); PG8_STAGE(PG8_SB(0, 1), cB + hstepB, voffB); PG8_STAGE(PG8_SA(0, 0), cA, voffA); PG8_STAGE(PG8_SA(0, 1), cA + hstepA, voffA);
        if (wr == 1) PG8_BAR;
        PG8_WAIT_V(2); PG8_BAR;
        PG8_STAGE(PG8_SB(1, 0), cB + kstep, voffB); PG8_STAGE(PG8_SA(1, 0), cA + kstep, voffA); PG8_STAGE(PG8_SB(1, 1), cB + hstepB + kstep, voffB);
        PG8_WAIT_V(6); PG8_BAR;
    } else {
        PG8_STAGE(PG8_SB(0, 0), cB, voffB); PG8_STAGE(PG8_SA(0, 0), cA, voffA); PG8_STAGE(PG8_SB(0, 1), cB + hstepB, voffB); PG8_STAGE(PG8_SA(0, 1), cA + hstepA, voffA);
        if (wr == 1) PG8_BAR;
        PG8_WAIT_V(4); PG8_BAR;
        PG8_STAGE(PG8_SB(1, 0), cB + kstep, voffB); PG8_STAGE(PG8_SA(1, 0), cA + kstep, voffA); PG8_STAGE(PG8_SB(1, 1), cB + hstepB + kstep, voffB);
        PG8_WAIT_V(6); PG8_BAR;
    }
    for (;;) {
        const bool has_next = S.next(ui + 1, nxt);
        const char* nA = has_next ? (const char*)g.A + (size_t)nxt.pm * tstepA + (size_t)nxt.pn * apn : cA; const char* nB = has_next ? (const char*)g.Bt + (size_t)nxt.pn * tstepB : cB;
        for (int t = 0; t < nt; t += 2) {
            const bool last = (t == nt - 2);
            const char* a1 = cA + (size_t)(t + 1) * kstep;
            const char* a2 = last ? nA : cA + (size_t)(t + 2) * kstep; const char* b2 = last ? nB : cB + (size_t)(t + 2) * kstep;
            const char* a3 = a2 + kstep; const char* b3 = b2 + kstep;
            if (last && has_next) S.a_ready(nxt);
            if constexpr (SP2) {
            PG8_LDB(B0, 0, 0); PG8_LDB(B1, 0, 1); PG8_SCHED; PG8_LDA(At, 0, 0); PG8_STAGE(PG8_SA(1, 1), a1 + hstepA, voffA);
            PG8_WAIT_V(8); PG8_WAIT_L(0); PG8_BAR; PG8_MMA(0, 0, At, B0); PG8_MMA(0, 1, At, B1); PG8_BAR; PG8_SCHED;
            PG8_LDA(At, 0, 1); PG8_STAGE(PG8_SB(0, 0), b2, voffB); PG8_STAGE(PG8_SB(0, 1), b2 + hstepB, voffB); PG8_STAGE(PG8_SA(0, 0), a2, voffA);
            PG8_WAIT_V(8); PG8_WAIT_L(0); PG8_BAR; PG8_MMA(1, 0, At, B0); PG8_MMA(1, 1, At, B1); PG8_BAR; PG8_SCHED;
            PG8_LDB(B0, 1, 0); PG8_LDB(B1, 1, 1); PG8_SCHED; PG8_LDA(At, 1, 0); PG8_STAGE(PG8_SA(0, 1), a2 + hstepA, voffA);
            PG8_WAIT_V(8); PG8_WAIT_L(0); PG8_BAR; PG8_MMA(0, 0, At, B0); PG8_MMA(0, 1, At, B1); PG8_BAR; PG8_SCHED;
            PG8_LDA(At, 1, 1); PG8_STAGE(PG8_SB(1, 0), b3, voffB); PG8_STAGE(PG8_SB(1, 1), b3 + hstepB, voffB); PG8_STAGE(PG8_SA(1, 0), a3, voffA);
            PG8_WAIT_V(8); PG8_WAIT_L(0); PG8_BAR; PG8_MMA(1, 0, At, B0); PG8_MMA(1, 1, At, B1); PG8_BAR; PG8_SCHED;
            } else {
            PG8_LDB(B0, 0, 0); PG8_SCHED; PG8_LDA(At, 0, 0); PG8_STAGE(PG8_SA(1, 1), a1 + hstepA, voffA);
            PG8_WAIT_L(8); PG8_BAR; PG8_WAIT_L(0); PG8_MMA(0, 0, At, B0); PG8_BAR; PG8_SCHED;
            PG8_LDB(B1, 0, 1); PG8_STAGE(PG8_SB(0, 0), b2, voffB);
            PG8_BAR; PG8_WAIT_L(0); PG8_MMA(0, 1, At, B1); PG8_BAR;
            PG8_LDA(At, 0, 1); PG8_STAGE(PG8_SA(0, 0), a2, voffA);
            PG8_BAR; PG8_WAIT_L(0); PG8_MMA(1, 0, At, B0); PG8_BAR; PG8_SCHED;
            PG8_STAGE(PG8_SB(0, 1), b2 + hstepB, voffB);
            PG8_WAIT_V(6); PG8_BAR; PG8_MMA(1, 1, At, B1); PG8_BAR;
            PG8_LDB(B0, 1, 0); PG8_SCHED; PG8_LDA(At, 1, 0); PG8_STAGE(PG8_SA(0, 1), a2 + hstepA, voffA);
            PG8_WAIT_L(8); PG8_BAR; PG8_WAIT_L(0); PG8_MMA(0, 0, At, B0); PG8_BAR; PG8_SCHED;
            PG8_LDB(B1, 1, 1); PG8_STAGE(PG8_SB(1, 0), b3, voffB);
            PG8_BAR; PG8_WAIT_L(0); PG8_MMA(0, 1, At, B1); PG8_BAR;
            PG8_LDA(At, 1, 1); PG8_STAGE(PG8_SA(1, 0), a3, voffA);
            PG8_BAR; PG8_WAIT_L(0); PG8_MMA(1, 0, At, B0); PG8_BAR; PG8_SCHED;
            PG8_STAGE(PG8_SB(1, 1), b3 + hstepB, voffB);
            PG8_WAIT_V(6); PG8_BAR; PG8_MMA(1, 1, At, B1); PG8_BAR;
            }
        }
        if constexpr (ALIGN_EPI) { if (wr == 0) PG8_BAR; }
        if constexpr (!Epi::AFTER_DRAIN) { E(acc, cur, wr, wc, fr, fq); S.done(cur); }
        if (!has_next) break;
#pragma unroll
        for (int a = 0; a < 2; ++a)
#pragma unroll
            for (int b = 0; b < 2; ++b)
#pragma unroll
                for (int m = 0; m < 4; ++m)
#pragma unroll
                    for (int n = 0; n < 2; ++n) acc[a][b][m][n] = (f32x4){0.f, 0.f, 0.f, 0.f};
        cur = nxt; cA = nA; cB = nB; ++ui;
        if constexpr (ALIGN_EPI) { if (wr == 1) PG8_BAR; }
    }
    PG8_WAIT_V(0);
    if constexpr (!ALIGN_EPI) { if (wr == 0) PG8_BAR; }
    PG8_BAR;
    if constexpr (Epi::AFTER_DRAIN) { E.fused(acc, cur, wr, wc, fr, fq, lds, wid, lane); S.done(cur); }
#undef PG8_SA
#undef PG8_SB
#undef PG8_STAGE
#undef PG8_LDA
#undef PG8_LDB
#undef PG8_MMA
#undef PG8_WAIT_V
#undef PG8_WAIT_L
#undef PG8_BAR
#undef PG8_SCHED
}
}
#include <hip/hip_bf16.h>
#include <cmath>
namespace attn_body {
using bf16=__hip_bfloat16;
using bf16x8=__attribute__((ext_vector_type(8)))short;
using s16x4=__attribute__((ext_vector_type(4)))short;
using f32x16=__attribute__((ext_vector_type(16)))float;
using u32x4=__attribute__((ext_vector_type(4)))unsigned;
constexpr int BATCH=4,NHEAD=32,SEQ=4096,D=64,PQ=1024,PO=2048;
constexpr int NW=8,QBLK=32,QB=QBLK*NW,KVBLK=64,NQB=SEQ/QB;
constexpr int ATTN_UNIT_ROWS=QB;
__device__ __forceinline__ int crow(int r,int hi){return (r&3)+8*(r>>2)+4*hi;}
#define SBAR() __builtin_amdgcn_sched_barrier(0)
__device__ __forceinline__ void cmask(f32x16&p0,f32x16&p1,int jb,int qrel,int hi){
  const float NEG=-INFINITY; int kb=64*jb+4*hi;
  #pragma unroll
  for(int r=0;r<16;++r){int kv=kb+(r&3)+8*(r>>2); if(kv>qrel)p0[r]=NEG; if(kv+32>qrel)p1[r]=NEG;}
}

constexpr int NSLOT=3, SLOTB=8192;
constexpr int LDS_K=0, LDS_V=NSLOT*SLOTB, LDS_WS=2*NSLOT*SLOTB, LDS_OST=LDS_WS+NW*64*4, LDS_BYTES=LDS_OST+NW*4096;
constexpr float C2=0.125f*1.4426950408889634f;
__device__ __forceinline__ void glds16(const void*gsrc,unsigned lds_dst){unsigned keep;
  asm volatile("s_mov_b32 %0, m0\n\ts_mov_b32 m0, %2\n\ts_nop 0\n\tglobal_load_lds_dwordx4 %1, off\n\ts_mov_b32 m0, %0":"=&s"(keep):"v"(gsrc),"s"(lds_dst):"memory");}
__device__ __forceinline__ float max3f(float a,float b,float c){float r;asm("v_max3_f32 %0, %1, %2, %3":"=v"(r):"v"(a),"v"(b),"v"(c));return r;}
__device__ __forceinline__ float max2f(float a,float b){float r;asm("v_max_f32_e32 %0, %1, %2":"=v"(r):"v"(a),"v"(b));return r;}
__device__ __forceinline__ float fadd_s(float a,float b){float r;asm("v_add_f32_e32 %0, %1, %2":"=v"(r):"v"(a),"v"(b));return r;}
__device__ __forceinline__ float fsub_s(float a,float b){float r;asm("v_sub_f32_e32 %0, %1, %2":"=v"(r):"v"(a),"v"(b));return r;}
typedef float f32x2_t __attribute__((ext_vector_type(2))); typedef __bf16 bf16x2_t __attribute__((ext_vector_type(2)));
__device__ __forceinline__ unsigned cvtpk_s(float lo,float hi){f32x2_t v={lo,hi};bf16x2_t b=__builtin_convertvector(v,bf16x2_t);return __builtin_bit_cast(unsigned,b);}
#define WAIT_BAR(N) asm volatile("s_waitcnt vmcnt(" #N ") lgkmcnt(0)\n\ts_barrier":::"memory")

__device__ __forceinline__ void qkt(f32x16&p0,f32x16&p1,const char*Kslot,const bf16x8*qr,const f32x16&negm,int r32,int hi){
  const char*kb=Kslot+hi*1024+r32*16;
  #pragma unroll
  for(int d0=0;d0<4;++d0){
    const bf16x8 b0=*reinterpret_cast<const bf16x8*>(kb+d0*2048);
    const bf16x8 b1=*reinterpret_cast<const bf16x8*>(kb+d0*2048+512);
    if(d0==0){p0=__builtin_amdgcn_mfma_f32_32x32x16_bf16(b0,qr[0],negm,0,0,0);p1=__builtin_amdgcn_mfma_f32_32x32x16_bf16(b1,qr[0],negm,0,0,0);}
    else{p0=__builtin_amdgcn_mfma_f32_32x32x16_bf16(b0,qr[d0],p0,0,0,0);p1=__builtin_amdgcn_mfma_f32_32x32x16_bf16(b1,qr[d0],p1,0,0,0);}}
}
typedef __attribute__((address_space(3))) const char* lds_cptr;
typedef short v4i16_t __attribute__((ext_vector_type(4)));
__device__ __forceinline__ void kload8(bf16x8*kf,lds_cptr kp){
  kf[0]=*(const __attribute__((address_space(3))) bf16x8*)(kp);      kf[1]=*(const __attribute__((address_space(3))) bf16x8*)(kp+512);
  kf[2]=*(const __attribute__((address_space(3))) bf16x8*)(kp+2048); kf[3]=*(const __attribute__((address_space(3))) bf16x8*)(kp+2560);
  kf[4]=*(const __attribute__((address_space(3))) bf16x8*)(kp+4096); kf[5]=*(const __attribute__((address_space(3))) bf16x8*)(kp+4608);
  kf[6]=*(const __attribute__((address_space(3))) bf16x8*)(kp+6144); kf[7]=*(const __attribute__((address_space(3))) bf16x8*)(kp+6656);
}
__device__ __forceinline__ void kload2(bf16x8*kf,lds_cptr kp,int j){ kf[2*j]=*(const __attribute__((address_space(3))) bf16x8*)(kp+j*2048); kf[2*j+1]=*(const __attribute__((address_space(3))) bf16x8*)(kp+j*2048+512); }
__device__ __forceinline__ s16x4 vtr(lds_cptr p){ return __builtin_bit_cast(s16x4,__builtin_amdgcn_ds_read_tr16_b64_v4i16((__attribute__((address_space(3))) v4i16_t*)p)); }
__device__ __forceinline__ float rowmax(const f32x16&p0,const f32x16&p1){
  float a=max3f(p0[0],p0[1],p1[0]),b=max3f(p0[2],p0[3],p1[1]);a=max3f(a,p1[2],p1[3]);
  #pragma unroll
  for(int r=4;r<16;r+=4){a=max3f(a,p0[r],p0[r+1]);b=max3f(b,p0[r+2],p0[r+3]);a=max3f(a,p1[r],p1[r+1]);b=max3f(b,p1[r+2],p1[r+3]);}
  const float m=max2f(a,b);
  auto rr=__builtin_amdgcn_permlane32_swap(__float_as_uint(m),__float_as_uint(m),false,false);
  return max2f(__uint_as_float(rr[0]),__uint_as_float(rr[1]));
}
__device__ __forceinline__ void pv(f32x16*o,int vb,bf16x8 pa0,bf16x8 pa1,bf16x8 pa2,bf16x8 pa3){
  #pragma unroll
  for(int d0=0;d0<2;++d0){s16x4 lo[4],hi[4];
    #pragma unroll
    for(int ks=0;ks<4;++ks){
      asm volatile("ds_read_b64_tr_b16 %0,%1 offset:%c2":"=&v"(lo[ks]):"v"(vb),"i"(d0*4096+ks*1024):"memory");
      asm volatile("ds_read_b64_tr_b16 %0,%1 offset:%c2":"=&v"(hi[ks]):"v"(vb),"i"(d0*4096+ks*1024+512):"memory");}
    asm volatile("s_waitcnt lgkmcnt(0)":::"memory");SBAR();
    #define PK(k) (bf16x8){lo[k][0],lo[k][1],lo[k][2],lo[k][3],hi[k][0],hi[k][1],hi[k][2],hi[k][3]}
    o[d0]=__builtin_amdgcn_mfma_f32_32x32x16_bf16(pa0,PK(0),o[d0],0,0,0);
    o[d0]=__builtin_amdgcn_mfma_f32_32x32x16_bf16(pa1,PK(1),o[d0],0,0,0);
    o[d0]=__builtin_amdgcn_mfma_f32_32x32x16_bf16(pa2,PK(2),o[d0],0,0,0);
    o[d0]=__builtin_amdgcn_mfma_f32_32x32x16_bf16(pa3,PK(3),o[d0],0,0,0);
    #undef PK
  }
}

#ifndef ATTN_STORE16
#define ATTN_STORE16(p,v) (*(u32x4*)(p)=(v))
#endif
template<int THRL> __device__ __forceinline__ void attn_unit(int b,int vh,int qb,const bf16*Q,const bf16*__restrict__ K,const bf16*__restrict__ V,bf16*O,char*shm){
  int tid_=threadIdx.x; asm volatile("":"+v"(tid_)); const int tid=tid_,lane=tid&63,r32=lane&31,hi=lane>>5; const int wid=__builtin_amdgcn_readfirstlane(tid>>6);
  const long rowbase=(long)b*SEQ; const int q0=qb*QB;
  const int qcol=(vh>>2)*128+((vh>>1)&1)*64, vcol=(vh>>2)*128+(vh&1)*64, ocol=vh*64;
  const bf16*Qw=Q+(rowbase+q0+wid*QBLK)*PQ+qcol;
  const bf16*Kh=K+rowbase*PQ+qcol,*Vh=V+rowbase*PQ+vcol;
  const unsigned lds0=(unsigned)(uintptr_t)shm;
  float*wsf=(float*)(shm+LDS_WS)+wid*64;
  const bf16*ksrc=Kh+(long)lane*PQ+wid*8;
  const bf16*vsrc=Vh+(long)(16*(wid&3)+(lane>>2))*PQ+(wid>>2)*32+(lane&3)*8;
  const unsigned kdst=lds0+LDS_K+wid*1024, vdst=lds0+LDS_V+wid*1024;
  #define DMA_K(t,slot) glds16(ksrc+(long)(t)*KVBLK*PQ,(unsigned)__builtin_amdgcn_readfirstlane(kdst+(slot)))
  #define DMA_V(t,slot) glds16(vsrc+(long)(t)*KVBLK*PQ,(unsigned)__builtin_amdgcn_readfirstlane(vdst+(slot)))
  const int vb0=(int)(lds0+LDS_V)+((lane>>4)&1)*32+(lane&3)*8+(4*hi+((lane&15)>>2))*64;
  const char*Kbase=shm+LDS_K; bf16x8 kf[8];
  const lds_cptr shm3=(lds_cptr)shm; const lds_cptr kp0=shm3+LDS_K+hi*1024+r32*16; const lds_cptr vp0=shm3+LDS_V+((lane>>4)&1)*32+(lane&3)*8+(4*hi+((lane&15)>>2))*64;
  const int NT=(q0+QB)/KVBLK;
  DMA_K(0,0);DMA_V(0,0);DMA_K(1,SLOTB);
  bf16x8 qr[4];
  #pragma unroll
  for(int d0=0;d0<4;++d0)qr[d0]=*reinterpret_cast<const bf16x8*>(&Qw[(long)r32*PQ+d0*16+hi*8]);
  float mhat=0.f,l_reg=0.f;f32x16 o[2];o[0]=f32x16{};o[1]=f32x16{};f32x16 negm=f32x16{};asm volatile("":"+v"(negm));
  const int qrel=wid*QBLK+r32;
  #define CMASK(P0,P1,t) do{int jb_=(t)-(NT-4); if(jb_>=0)cmask(P0,P1,jb_,qrel,hi);}while(0)
  bool resc=false;
  #define START(P0,P1) do{ const float rm=rowmax(P0,P1); resc=false; \
    { const float dl=rm; mhat=fadd_s(mhat,dl); \
      _Pragma("unroll") for(int r=0;r<16;++r){P0[r]=fsub_s(P0[r],dl);P1[r]=fsub_s(P1[r],dl);} \
      _Pragma("unroll") for(int r=0;r<16;++r)negm[r]=-mhat; asm volatile("":"+v"(negm)); } \
    _Pragma("unroll") for(int r=0;r<16;++r)P0[r]=__builtin_amdgcn_exp2f(P0[r]); }while(0)
  #define RESC() do{ if(resc){ asm volatile("s_waitcnt lgkmcnt(0)":::"memory"); \
      _Pragma("unroll") for(int d_=0;d_<2;++d_) _Pragma("unroll") for(int r=0;r<16;++r)o[d_][r]*=wsf[crow(r,hi)]; } }while(0)
  f32x16 pA0,pA1,pB0,pB1;
  int sl_prev=0,sl_cur=0,sl_next=SLOTB;
  #define ROT() do{sl_prev=sl_cur;sl_cur=sl_next;sl_next=(sl_next==(NSLOT-1)*SLOTB)?0:sl_next+SLOTB;}while(0)
  DMA_K(2,2*SLOTB);
  WAIT_BAR(3);
  qkt(pA0,pA1,Kbase,qr,negm,r32,hi);asm volatile("s_nop 15\n\ts_nop 7":"+v"(pA0),"+v"(pA1));CMASK(pA0,pA1,0);
  START(pA0,pA1);
  _Pragma("unroll") for(int r=0;r<16;++r)pA1[r]=__builtin_amdgcn_exp2f(pA1[r]);
  WAIT_BAR(0);
  DMA_K(3,0);DMA_V(1,SLOTB);
  ROT();
  kload8(kf,kp0+sl_cur);
  WAIT_BAR(2);
  s16x4 vlo[8],vhi[8]; u32x4 pw0,pw1,pw2,pw3;
  #define PKW(P,B) cvtpk_s(P[B],P[B+1])
  #define PAF(k) __builtin_bit_cast(bf16x8,pw##k)
  #define VFR(i) (bf16x8){vlo[i][0],vlo[i][1],vlo[i][2],vlo[i][3],vhi[i][0],vhi[i][1],vhi[i][2],vhi[i][3]}
  #define PIN(x) asm volatile("":"+v"(x))
  #define MX3(a,b,c) __builtin_fmaxf(__builtin_fmaxf((a),(b)),(c))
  #define GAPA(MF,A0,A1,A2,A3,W0,W1,PW) do{ MF; sacc+=A0; sacc+=A1; sacc+=A2; sacc+=A3; PIN(sacc); W0; W1; PIN(PW); SBAR(); }while(0)
  #define EX(v) __builtin_amdgcn_exp2f(v)
  #define GAPB(MF,X,B) do{ MF; X[B]=EX(X[B]); X[B+1]=EX(X[B+1]); X[B+2]=EX(X[B+2]); X[B+3]=EX(X[B+3]); PIN(X); SBAR(); }while(0)
  #define VRD(i) do{ vlo[i]=vtr(vp_+(((i)>>2)*4096+((i)&3)*1024)); vhi[i]=vtr(vp_+(((i)>>2)*4096+((i)&3)*1024+512)); }while(0)
  #define KRD(G,j) do{ if(G){ kload2(kf,kp0+sl_next,j); SBAR(); } }while(0)
  #define STEP(C0,C1,P0,P1,t,GK,GV,GL) do{ SBAR(); \
    const lds_cptr vp_=vp0+sl_prev; \
    VRD(0); SBAR(); float sacc=(P0[0]+P0[1]); \
    GAPA(C0=__builtin_amdgcn_mfma_f32_32x32x16_bf16(kf[0],qr[0],negm,0,0,0), P0[2],P0[3],P0[4],P0[5],     pw0[0]=PKW(P0,0), pw0[1]=PKW(P0,2), pw0); \
    VRD(4); SBAR(); GAPA(C1=__builtin_amdgcn_mfma_f32_32x32x16_bf16(kf[1],qr[0],negm,0,0,0), P0[6],P0[7],P0[8],P0[9],     pw0[2]=PKW(P0,4), pw0[3]=PKW(P0,6), pw0); \
    VRD(1); SBAR(); GAPA(C0=__builtin_amdgcn_mfma_f32_32x32x16_bf16(kf[2],qr[1],C0,0,0,0),   P0[10],P0[11],P0[12],P0[13], pw1[0]=PKW(P0,8), pw1[1]=PKW(P0,10), pw1); \
    VRD(5); SBAR(); GAPA(C1=__builtin_amdgcn_mfma_f32_32x32x16_bf16(kf[3],qr[1],C1,0,0,0),   P0[14],P0[15],P1[0],P1[1],   pw1[2]=PKW(P0,12),pw1[3]=PKW(P0,14), pw1); \
    VRD(2); SBAR(); GAPA(C0=__builtin_amdgcn_mfma_f32_32x32x16_bf16(kf[4],qr[2],C0,0,0,0),   P1[2],P1[3],P1[4],P1[5],     pw2[0]=PKW(P1,0), pw2[1]=PKW(P1,2), pw2); \
    VRD(6); SBAR(); GAPA(C1=__builtin_amdgcn_mfma_f32_32x32x16_bf16(kf[5],qr[2],C1,0,0,0),   P1[6],P1[7],P1[8],P1[9],     pw2[2]=PKW(P1,4), pw2[3]=PKW(P1,6), pw2); \
    VRD(3); SBAR(); GAPA(C0=__builtin_amdgcn_mfma_f32_32x32x16_bf16(kf[6],qr[3],C0,0,0,0),   P1[10],P1[11],P1[12],P1[13], pw3[0]=PKW(P1,8), pw3[1]=PKW(P1,10), pw3); \
    VRD(7); SBAR(); GAPA(C1=__builtin_amdgcn_mfma_f32_32x32x16_bf16(kf[7],qr[3],C1,0,0,0),   P1[14],P1[15],0.f,0.f,       pw3[2]=PKW(P1,12),pw3[3]=PKW(P1,14), pw3); \
    l_reg+=sacc; \
    if(GK){DMA_K((t)+3,sl_cur);} if(GV){DMA_V((t)+1,sl_next);} \
    CMASK(C0,C1,t); \
    { float a=MX3(C0[0],C0[1],C1[0]),b=MX3(C0[2],C0[3],C1[1]); a=MX3(a,C1[2],C1[3]); \
      _Pragma("unroll") for(int r=4;r<16;r+=4){a=MX3(a,C0[r],C0[r+1]);b=MX3(b,C0[r+2],C0[r+3]);a=MX3(a,C1[r],C1[r+1]);b=MX3(b,C1[r+2],C1[r+3]);} \
      float rm=__builtin_fmaxf(a,b); { auto rr=__builtin_amdgcn_permlane32_swap(__float_as_uint(rm),__float_as_uint(rm),false,false); rm=__builtin_fmaxf(__uint_as_float(rr[0]),__uint_as_float(rr[1])); } \
      resc=false; \
      if(__builtin_expect(__any(rm>(float)THRL),0)){ const float dl=__builtin_fmaxf(rm,0.f); mhat+=dl; \
        _Pragma("unroll") for(int r=0;r<16;++r){C0[r]-=dl;C1[r]-=dl;} \
        _Pragma("unroll") for(int r=0;r<16;++r)negm[r]=-mhat; asm volatile("":"+v"(negm)); \
        const float f=__builtin_amdgcn_exp2f(-dl); l_reg*=f; if(hi==0)wsf[r32]=f; resc=true; } } \
    SBAR(); \
    GAPB(o[0]=__builtin_amdgcn_mfma_f32_32x32x16_bf16(PAF(0),VFR(0),o[0],0,0,0), C0,0); \
    GAPB(o[1]=__builtin_amdgcn_mfma_f32_32x32x16_bf16(PAF(0),VFR(4),o[1],0,0,0), C0,4); \
    KRD(GL,0); GAPB(o[0]=__builtin_amdgcn_mfma_f32_32x32x16_bf16(PAF(1),VFR(1),o[0],0,0,0), C0,8); \
    KRD(GL,1); GAPB(o[1]=__builtin_amdgcn_mfma_f32_32x32x16_bf16(PAF(1),VFR(5),o[1],0,0,0), C0,12); \
    KRD(GL,2); GAPB(o[0]=__builtin_amdgcn_mfma_f32_32x32x16_bf16(PAF(2),VFR(2),o[0],0,0,0), C1,0); \
    KRD(GL,3); GAPB(o[1]=__builtin_amdgcn_mfma_f32_32x32x16_bf16(PAF(2),VFR(6),o[1],0,0,0), C1,4); \
    GAPB(o[0]=__builtin_amdgcn_mfma_f32_32x32x16_bf16(PAF(3),VFR(3),o[0],0,0,0), C1,8); \
    GAPB(o[1]=__builtin_amdgcn_mfma_f32_32x32x16_bf16(PAF(3),VFR(7),o[1],0,0,0), C1,12); \
    }while(0)
  int t=1;
  #undef CMASK
  #define CMASK(P0,P1,t) do{}while(0)
  for(;t+5<NT;t+=2){
    STEP(pB0,pB1,pA0,pA1,t,true,true,true);     WAIT_BAR(2); RESC(); ROT();
    STEP(pA0,pA1,pB0,pB1,t+1,true,true,true);   WAIT_BAR(2); RESC(); ROT();
  }
  #undef CMASK
  #define CMASK(P0,P1,t) do{int jb_=(t)-(NT-4); if(jb_>=0)cmask(P0,P1,jb_,qrel,hi);}while(0)
  #define ENDW(tt) do{ if((tt)+3<NT){WAIT_BAR(2);} else if((tt)+2<NT){WAIT_BAR(1);} else {WAIT_BAR(0);} }while(0)
  for(;t+1<NT;t+=2){
    STEP(pB0,pB1,pA0,pA1,t,(t+3<NT),(t+1<NT),(t+1<NT));       ENDW(t);   RESC(); ROT();
    STEP(pA0,pA1,pB0,pB1,t+1,(t+4<NT),(t+2<NT),(t+2<NT));     ENDW(t+1); RESC(); ROT();
  }
  STEP(pB0,pB1,pA0,pA1,NT-1,false,false,false); RESC();
  { float sacc=pB0[0]+pB0[1]; _Pragma("unroll") for(int r=2;r<16;++r)sacc+=pB0[r]; _Pragma("unroll") for(int r=0;r<16;++r)sacc+=pB1[r]; l_reg+=sacc;
    pw0=(u32x4){PKW(pB0,0),PKW(pB0,2),PKW(pB0,4),PKW(pB0,6)};pw1=(u32x4){PKW(pB0,8),PKW(pB0,10),PKW(pB0,12),PKW(pB0,14)};pw2=(u32x4){PKW(pB1,0),PKW(pB1,2),PKW(pB1,4),PKW(pB1,6)};pw3=(u32x4){PKW(pB1,8),PKW(pB1,10),PKW(pB1,12),PKW(pB1,14)};
    SBAR(); pv(o,vb0+sl_cur,PAF(0),PAF(1),PAF(2),PAF(3)); }
  #undef PKW
  #undef PAF
  #undef VFR
  #undef PIN
  #undef MX3
  #undef GAPA
  #undef GAPB
  #undef EX
  #undef VRD
  #undef KRD
  #undef STEP
  #undef ENDW
  {auto rr=__builtin_amdgcn_permlane32_swap(__float_as_uint(l_reg),__float_as_uint(l_reg),false,false);l_reg=__uint_as_float(rr[0])+__uint_as_float(rr[1]);}
  if(hi==0)wsf[32+r32]=l_reg;asm volatile("s_waitcnt lgkmcnt(0)":::"memory");
  float rli[16];
  #pragma unroll
  for(int r=0;r<16;++r)rli[r]=__builtin_amdgcn_rcpf(wsf[32+crow(r,hi)]);
  bf16*Ow=O+(rowbase+q0+wid*QBLK)*PO+ocol;
  { bf16*stg=(bf16*)(shm+LDS_OST)+wid*2048;
    #pragma unroll
    for(int r=0;r<16;++r){const int orow=crow(r,hi);
      #pragma unroll
      for(int d0=0;d0<2;++d0)stg[orow*64+d0*32+r32]=__float2bfloat16(o[d0][r]*rli[r]);}
    asm volatile("s_waitcnt lgkmcnt(0)":::"memory");
    #pragma unroll
    for(int i=0;i<4;++i){const int row=i*8+(lane>>3),ch=lane&7; const u32x4 v=*(const u32x4*)(stg+row*64+ch*8); ATTN_STORE16(Ow+(long)row*PO+ch*8,v);} }
  asm volatile("s_waitcnt lgkmcnt(0)\n\ts_barrier":::"memory");
  #undef DMA_K
  #undef DMA_V
  #undef CMASK
  #undef START
  #undef RESC
  #undef ROT
}
constexpr int ATTN_LDS_BYTES=LDS_BYTES;
struct AttnTensors { const bf16* Q; const bf16* K; const bf16* V; bf16* O; };
struct AttnUnit { int bh; int qb; };
struct StaticOrder {
  int vcu, G;
  __device__ __forceinline__ explicit StaticOrder(int grid,int block):vcu((grid%8==0)?(block%8)*(grid/8)+block/8:block),G(grid){}
  __device__ __forceinline__ bool next(int i,AttnUnit&u)const{
    if(G==256){ if(i>=8)return false; const int s=vcu&1; u.bh=vcu>>1; u.qb=2*i+((i&1)^s); return true; }
    const int L=i*G+vcu; if(L>=BATCH*NHEAD*NQB)return false; u.bh=L/NQB; u.qb=NQB-1-(L%NQB); return true; }
  __device__ __forceinline__ void a_ready(const AttnUnit&)const{}
  __device__ __forceinline__ void done(const AttnUnit&)const{}
};
template<class Sched,int THRL=8> __device__ __forceinline__ void attn_phase(char*lds,const AttnTensors&T,const Sched&S){
  AttnUnit u;
  for(int i=0;S.next(i,u);++i){ S.a_ready(u); attn_unit<THRL>(u.bh/NHEAD,u.bh%NHEAD,u.qb,T.Q,T.K,T.V,T.O,lds); S.done(u); }
}
#undef SBAR
#undef WAIT_BAR
}
namespace cg = cooperative_groups;
#ifndef REP_P0
#define REP_P0 1
#endif
#ifndef REP_P1
#define REP_P1 1
#endif
#ifndef REP_P2
#define REP_P2 1
#endif
#ifndef REP_P2b
#define REP_P2b 1
#endif
#ifndef REP_P2c
#define REP_P2c 1
#endif
#ifndef REP_P3
#define REP_P3 1
#endif
#ifndef REP_P3b
#define REP_P3b 1
#endif
#ifndef REP_P4
#define REP_P4 1
#endif
#ifndef REP_P6
#define REP_P6 1
#endif
#ifndef EXTRA_SYNCS
#define EXTRA_SYNCS 0
#endif

#ifndef PG_ALIGN
#define PG_ALIGN true
#endif
#ifndef PG_SP2
#define PG_SP2 true
#endif
constexpr int NWAVES = 8;
constexpr int BATCH = 4, SEQ = 4096, DMODEL = 1024, DIN = 2048, INCOLS = 6144, M = BATCH * SEQ;
constexpr size_t MiB = 1u << 20;
constexpr size_t WS_BAR = 16384;
constexpr size_t WS_WIN = 1 * MiB;
constexpr size_t WS_WOUT = 13 * MiB;
constexpr size_t WS_POOLW = 17 * MiB;
constexpr size_t WS_ROPE = 17 * MiB + 512 * 1024;
constexpr size_t WS_A = 19 * MiB;
constexpr size_t WS_Q = 51 * MiB, WS_K = 83 * MiB, WS_V = 115 * MiB;
constexpr size_t WS_Y = 51 * MiB;
constexpr size_t WS_XN = 147 * MiB;
constexpr size_t WS_O = 179 * MiB;
constexpr size_t WS_OUT0 = 179 * MiB;
constexpr size_t WS_STATS = 51 * MiB;
constexpr size_t WS_U = 56 * MiB, WS_V1 = 120 * MiB, WS_G1 = 184 * MiB;
constexpr size_t WS_OUT1 = 120 * MiB;
constexpr size_t WS_WOUT1 = 248 * MiB;
constexpr size_t WS_SGUW = 252 * MiB;
constexpr size_t WS_END = 253 * MiB;
constexpr int LDS_BYTES = 147456;
#define GAS __attribute__((address_space(1)))
#define LAS __attribute__((address_space(3)))
typedef unsigned short bf16;
typedef unsigned v4u __attribute__((ext_vector_type(4)));
typedef unsigned v2u __attribute__((ext_vector_type(2)));
typedef float f32x4 __attribute__((ext_vector_type(4)));
typedef short bf16x8 __attribute__((ext_vector_type(8)));
#define LDS_WAIT() asm volatile("s_waitcnt lgkmcnt(0)" ::: "memory")
__device__ __forceinline__ unsigned f2bf(float f) { unsigned u = __builtin_bit_cast(unsigned, f); return (u + 0x7fffu + ((u >> 16) & 1u)) >> 16; }
__device__ __forceinline__ unsigned pk2(float lo, float hi) { return pg8::cvt_pk_bf16(lo, hi); }
__device__ __forceinline__ float bflo(unsigned w) { return __uint_as_float(w << 16); }
__device__ __forceinline__ float bfhi(unsigned w) { return __uint_as_float(w & 0xffff0000u); }
__device__ __forceinline__ float wave_sum(float v) {
    v += pg8::swz_xor<1>(v); v += pg8::swz_xor<2>(v); v += pg8::swz_xor<4>(v); v += pg8::swz_xor<8>(v); v += pg8::swz_xor<16>(v);
    return pg8::half_sum(v);
}
#define XB_TMO      128
#define XB_XCNT(j)  (256  + 64 * (j))
#define XB_XSUB(j)  (1280 + 64 * (j))
#define XB_XGEN(j)  (2304 + 64 * (j))
#define XB_TOP      3328
#define XB_TOPGEN   3392
#define XCD_BAR_WORDS 3456
#define XB_SPIN_CAP (1u << 18)

__device__ __forceinline__ unsigned xb_ld(unsigned* p)              { return __hip_atomic_load(p, __ATOMIC_RELAXED, __HIP_MEMORY_SCOPE_AGENT); }
__device__ __forceinline__ unsigned xb_add(unsigned* p, unsigned v) { return __hip_atomic_fetch_add(p, v, __ATOMIC_RELAXED, __HIP_MEMORY_SCOPE_AGENT); }
__device__ __forceinline__ unsigned xb_xcc_id() { return (unsigned)__builtin_amdgcn_s_getreg((3 << 11) | 20) & 0xFu; }
#define XB_SPIN(cond, bar) do { unsigned _sp = 0; while (cond) { __builtin_amdgcn_s_sleep(1); \
    if ((++_sp & 255u) == 0u) { if (xb_ld(&(bar)[XB_TMO])) break; if (_sp > XB_SPIN_CAP) { atomicAdd(&(bar)[XB_TMO], 1u); break; } } } } while (0)

struct XcdBarrier {
    unsigned* bar; unsigned x;
    volatile LAS unsigned* st;
};

__device__ __forceinline__ XcdBarrier xcd_barrier_post(unsigned* bar, volatile LAS unsigned* st) {
    XcdBarrier b; b.bar = bar; b.x = xb_xcc_id(); b.st = st;
    if (threadIdx.x == 0) (void)xb_add(&bar[XB_XCNT(b.x)], 1u);
    return b;
}
__device__ __forceinline__ void xcd_barrier_complete(unsigned* bar, unsigned x, unsigned& nloc, unsigned& nx) {
    const unsigned G = gridDim.x * gridDim.y * gridDim.z;
    unsigned sum, cnt, mine, sp = 0u;
    for (;;) {
        sum = 0u; cnt = 0u; mine = 0u;
#pragma unroll
        for (unsigned j = 0; j < 16; ++j) { const unsigned c = xb_ld(&bar[XB_XCNT(j)]); sum += c; cnt += (c > 0u) ? 1u : 0u; mine = (j == x) ? c : mine; }
        if (sum == G) break;
        __builtin_amdgcn_s_sleep(1);
        if ((++sp & 255u) == 0u) { if (xb_ld(&bar[XB_TMO])) break; if (sp > XB_SPIN_CAP) { atomicAdd(&bar[XB_TMO], 1u); break; } }
    }
    nloc = mine > 0u ? mine : 1u; nx = cnt > 0u ? cnt : 1u;
}

__device__ __forceinline__ void xcd_barrier(const XcdBarrier& b) {
    asm volatile("s_waitcnt vmcnt(0)" ::: "memory");
    __syncthreads();
    if (threadIdx.x == 0) {
        unsigned* bar = b.bar;
        __builtin_amdgcn_s_waitcnt(0);
        unsigned nloc = b.st[0], nx = b.st[1];
        if (nloc == 0u) { xcd_barrier_complete(bar, b.x, nloc, nx); b.st[0] = nloc; b.st[1] = nx; }
        const unsigned old = xb_add(&bar[XB_XSUB(b.x)], 1u);
        const unsigned gen = old / nloc;
        if (old + 1u == (gen + 1u) * nloc) {
            __builtin_amdgcn_fence(__ATOMIC_RELEASE, "agent");
            asm volatile("s_waitcnt vmcnt(0)" ::: "memory");
            const unsigned og = xb_add(&bar[XB_TOP], 1u);
            const unsigned tg = og / nx;
            if (og + 1u == (tg + 1u) * nx) xb_add(&bar[XB_TOPGEN], 1u);
            else XB_SPIN(xb_ld(&bar[XB_TOPGEN]) == tg, bar);
            __builtin_amdgcn_fence(__ATOMIC_ACQUIRE, "agent");
            xb_add(&bar[XB_XGEN(b.x)], 1u);
            asm volatile("s_waitcnt vmcnt(0)" ::: "memory");
        } else {
            XB_SPIN(xb_ld(&bar[XB_XGEN(b.x)]) == gen, bar);
            __builtin_amdgcn_fence(__ATOMIC_ACQUIRE, "agent");
            asm volatile("s_waitcnt vmcnt(0)" ::: "memory");
        }
    }
    __syncthreads();
}
struct Frame { LAS unsigned char* lds; int tid, lane, wave, vcu, G; };
__device__ __forceinline__ unsigned long long ldp(LAS unsigned long long* PT, int k) { asm volatile("" ::: "memory"); const unsigned long long v = PT[k]; const unsigned lo = __builtin_amdgcn_readfirstlane((unsigned)v), hi = __builtin_amdgcn_readfirstlane((unsigned)(v >> 32)); return ((unsigned long long)hi << 32) | lo; }

__device__ __forceinline__ void p0_transpose_item(const float* W, int K, int N, bf16* WT, int row_off, LAS float* scr, int item, int lane) {
    const int nblk = N / 32, kb = item / nblk, nb = item % nblk, k0 = 64 * kb, n0 = 32 * nb;
#pragma unroll 8
    for (int i = 0; i < 32; ++i) { const int kk = 2 * i + (lane >> 5); scr[kk * 33 + (lane & 31)] = W[(size_t)(k0 + kk) * N + n0 + (lane & 31)]; }
    LDS_WAIT(); asm volatile("" ::: "memory");
    const int c = lane & 7;
#pragma unroll
    for (int j = 0; j < 4; ++j) { const int n = (lane >> 3) + 8 * j; const LAS float* s = scr + (8 * c) * 33 + n;
        v4u o; o.x = pk2(s[0 * 33], s[1 * 33]); o.y = pk2(s[2 * 33], s[3 * 33]); o.z = pk2(s[4 * 33], s[5 * 33]); o.w = pk2(s[6 * 33], s[7 * 33]);
        *(v4u*)(WT + (size_t)(row_off + n0 + n) * K + k0 + 8 * c) = o; }
    LDS_WAIT(); asm volatile("" ::: "memory");
}
__device__ __forceinline__ void rms_row_to_bf16(const float* xrow, const float* gain, bf16* orow, int lane) {
    const f32x4* xr = (const f32x4*)xrow + lane; const f32x4* gr = (const f32x4*)gain + lane;
    f32x4 v[4]; float s = 0.f;
#pragma unroll
    for (int j = 0; j < 4; ++j) { v[j] = xr[64 * j]; s += (v[j].x * v[j].x + v[j].y * v[j].y) + (v[j].z * v[j].z + v[j].w * v[j].w); }
    const float rstd = 1.f / sqrtf(wave_sum(s) * (1.f / DMODEL) + 1e-6f);
    v2u* o8 = (v2u*)orow + lane;
#pragma unroll
    for (int j = 0; j < 4; ++j) { const f32x4 g = gr[64 * j]; v2u w; w.x = pk2(v[j].x * rstd * g.x, v[j].y * rstd * g.y); w.y = pk2(v[j].z * rstd * g.z, v[j].w * rstd * g.w); o8[64 * j] = w; }
}
template <bool NEXT> __device__ __forceinline__ void post_row(const float* orow, const float* xin, const float* gpost, float* xout, const float* gpre, bf16* xn, int lane) {
    const f32x4* pr = (const f32x4*)orow + lane; const f32x4* xr = (const f32x4*)xin + lane; const f32x4* gr = (const f32x4*)gpost + lane;
    f32x4 v[4]; float s = 0.f;
#pragma unroll
    for (int j = 0; j < 4; ++j) { v[j] = pr[64 * j]; s += (v[j].x * v[j].x + v[j].y * v[j].y) + (v[j].z * v[j].z + v[j].w * v[j].w); }
    const float rstd = 1.f / sqrtf(wave_sum(s) * (1.f / DMODEL) + 1e-6f); float s2 = 0.f;
#pragma unroll
    for (int j = 0; j < 4; ++j) { v[j] = xr[64 * j] + v[j] * rstd * gr[64 * j]; ((f32x4*)xout + lane)[64 * j] = v[j]; s2 += (v[j].x * v[j].x + v[j].y * v[j].y) + (v[j].z * v[j].z + v[j].w * v[j].w); }
    if (NEXT) { const float r2 = 1.f / sqrtf(wave_sum(s2) * (1.f / DMODEL) + 1e-6f); const f32x4* g2 = (const f32x4*)gpre + lane; v2u* o8 = (v2u*)xn + lane;
#pragma unroll
        for (int j = 0; j < 4; ++j) { const f32x4 g = g2[64 * j]; v2u w; w.x = pk2(v[j].x * r2 * g.x, v[j].y * r2 * g.y); w.y = pk2(v[j].z * r2 * g.z, v[j].w * r2 * g.w); o8[64 * j] = w; } }
}
__device__ __forceinline__ void combine_row(const bf16* O, const bf16* G, const float* subln, bf16* Y, int row, float lam, int lane) {
    const int h = lane >> 3, j = lane & 7;
    const v4u* p0 = (const v4u*)(O + (size_t)row * 2048 + h * 256 + j * 16); const v4u* p1 = (const v4u*)(O + (size_t)row * 2048 + h * 256 + 128 + j * 16);
    const v4u a0 = p0[0], a1 = p0[1], b0 = p1[0], b1 = p1[1];
    float d[16];
#pragma unroll
    for (int k = 0; k < 4; ++k) { d[2 * k] = bflo(a0[k]) - lam * bflo(b0[k]); d[2 * k + 1] = bfhi(a0[k]) - lam * bfhi(b0[k]); d[8 + 2 * k] = bflo(a1[k]) - lam * bflo(b1[k]); d[8 + 2 * k + 1] = bfhi(a1[k]) - lam * bfhi(b1[k]); }
    float ss = 0.f;
#pragma unroll
    for (int k = 0; k < 16; ++k) ss += d[k] * d[k];
    ss += pg8::swz_xor<1>(ss); ss += pg8::swz_xor<2>(ss); ss += pg8::swz_xor<4>(ss);
    const float rstd = 0.8f / sqrtf(ss * (1.f / 128.f) + 1e-5f);
    const v4u* gp = (const v4u*)(G + (size_t)row * 2048 + 1024 + h * 128 + j * 16); const v4u g0 = gp[0], g1 = gp[1];
    const f32x4* sp = (const f32x4*)(subln + j * 16); const f32x4 s0 = sp[0], s1 = sp[1], s2 = sp[2], s3 = sp[3];
    const float sl[16] = {s0.x, s0.y, s0.z, s0.w, s1.x, s1.y, s1.z, s1.w, s2.x, s2.y, s2.z, s2.w, s3.x, s3.y, s3.z, s3.w};
    v4u o0, o1;
#pragma unroll
    for (int k = 0; k < 4; ++k) { o0[k] = pk2(d[2 * k] * rstd * sl[2 * k] * bflo(g0[k]), d[2 * k + 1] * rstd * sl[2 * k + 1] * bfhi(g0[k]));
        o1[k] = pk2(d[8 + 2 * k] * rstd * sl[8 + 2 * k] * bflo(g1[k]), d[8 + 2 * k + 1] * rstd * sl[8 + 2 * k + 1] * bfhi(g1[k])); }
    v4u* yp = (v4u*)(Y + (size_t)row * 2048 + 1024 + h * 128 + j * 16); yp[0] = o0; yp[1] = o1;
}
#ifdef PROBE_NOSKIP
#define SGU_TB0(ks) 0
#else
#define SGU_TB0(ks) (2 * (ks))
#endif
#ifndef ATT_THRL
#define ATT_THRL 8
#endif
constexpr int SG_W = 0, SG_VT = 34816, SG_ST = 34816 + 69632, SG_STRIDE = 272, SG_MSTRIDE = 528;
__device__ __forceinline__ void sgu_unit(const Frame& F, int ch, int g, bf16* U, const bf16* V, const bf16* G, const float* stats, const bf16* Wm, const float* lng, const float* lnb, const float* sgub) {
    LAS unsigned char* lds = F.lds; const int tid = F.tid, lane = F.lane, wave = F.wave; const int row0 = ch * 128;
    LAS float* ST = (LAS float*)(lds + SG_ST);
    if (tid < 128) { const f32x4* p = (const f32x4*)(stats + (size_t)(row0 + tid) * 64); float s = 0.f, q = 0.f;
#ifdef PROBE_STATS
        for (int k = 0; k < 256; ++k) { const v4u r = *(const v4u*)(V + (size_t)(row0 + tid) * 2048 + k * 8);
#pragma unroll
            for (int e = 0; e < 4; ++e) { const float lo = bflo(r[e]), hi = bfhi(r[e]); s += lo + hi; q += lo * lo + hi * hi; } }
#else
#pragma unroll
        for (int k = 0; k < 16; ++k) { const f32x4 t = p[k]; s += t.x + t.z; q += t.y + t.w; }
#endif
        const float mu = s * (1.f / 2048.f), var = q * (1.f / 2048.f) - mu * mu; ST[2 * tid] = mu; ST[2 * tid + 1] = 1.f / sqrtf(var + 1e-6f); }
#pragma unroll
    for (int i = 0; i < 4; ++i) { const int c = tid + 512 * i, t = c >> 4, k8 = c & 15; const v4u w = *(const v4u*)(Wm + (size_t)(g * 128 + t) * 128 + k8 * 8); *(LAS v4u*)(lds + SG_W + t * SG_STRIDE + k8 * 16) = w; }
    __syncthreads();
    { const int db = tid & 31, sb = tid >> 5, d0 = db * 8, s0 = sb * 8;
      const f32x4 ga = *(const f32x4*)(lng + g * 256 + d0), gb = *(const f32x4*)(lng + g * 256 + d0 + 4), ba = *(const f32x4*)(lnb + g * 256 + d0), bb = *(const f32x4*)(lnb + g * 256 + d0 + 4);
      const float gl[8] = {ga.x, ga.y, ga.z, ga.w, gb.x, gb.y, gb.z, gb.w}, bl[8] = {ba.x, ba.y, ba.z, ba.w, bb.x, bb.y, bb.z, bb.w};
      float f[8][8];
#pragma unroll
      for (int i = 0; i < 8; ++i) { const v4u raw = *(const v4u*)(V + (size_t)(row0 + s0 + i) * 2048 + g * 256 + d0); const float mu = ST[2 * (s0 + i)], rs = ST[2 * (s0 + i) + 1];
#pragma unroll
          for (int k = 0; k < 4; ++k) { f[i][2 * k] = (bflo(raw[k]) - mu) * rs * gl[2 * k] + bl[2 * k]; f[i][2 * k + 1] = (bfhi(raw[k]) - mu) * rs * gl[2 * k + 1] + bl[2 * k + 1]; } }
#pragma unroll
      for (int dd = 0; dd < 8; ++dd) { v4u w; w.x = pk2(f[0][dd], f[1][dd]); w.y = pk2(f[2][dd], f[3][dd]); w.z = pk2(f[4][dd], f[5][dd]); w.w = pk2(f[6][dd], f[7][dd]);
          *(LAS v4u*)(lds + SG_VT + (d0 + dd) * SG_STRIDE + s0 * 2) = w; } }
    __syncthreads();
    f32x4 acc[2][8];
#pragma unroll
    for (int a = 0; a < 2; ++a)
#pragma unroll
        for (int b = 0; b < 8; ++b) acc[a][b] = (f32x4){0.f, 0.f, 0.f, 0.f};
    const int fr = lane & 15, fq = lane >> 4;
#pragma unroll
    for (int ks = 0; ks < 4; ++ks) { bf16x8 af[2];
#pragma unroll
        for (int a = 0; a < 2; ++a) af[a] = *(const LAS bf16x8*)(lds + SG_VT + (32 * wave + 16 * a + fr) * SG_STRIDE + (32 * ks + 8 * fq) * 2);
#pragma unroll
        for (int tb = SGU_TB0(ks); tb < 8; ++tb) { const bf16x8 bfr = *(const LAS bf16x8*)(lds + SG_W + (16 * tb + fr) * SG_STRIDE + (32 * ks + 8 * fq) * 2);
#pragma unroll
            for (int a = 0; a < 2; ++a) acc[a][tb] = __builtin_amdgcn_mfma_f32_16x16x32_bf16(af[a], bfr, acc[a][tb], 0, 0, 0); } }
    __syncthreads();
#pragma unroll
    for (int a = 0; a < 2; ++a)
#pragma unroll
        for (int tb = 0; tb < 8; ++tb) { v2u w; w.x = pk2(acc[a][tb][0], acc[a][tb][1]); w.y = pk2(acc[a][tb][2], acc[a][tb][3]);
            *(LAS v2u*)(lds + SG_VT + (16 * tb + fr) * SG_MSTRIDE + (32 * wave + 16 * a + 4 * fq) * 2) = w; }
    __syncthreads();
#pragma unroll
    for (int i = 0; i < 8; ++i) { const int c = tid + 512 * i, t = c >> 5, d8 = c & 31; const size_t off = (size_t)(row0 + t) * 2048 + g * 256 + d8 * 8;
        const v4u uu = *(const v4u*)(U + off), gg = *(const v4u*)(G + off), mm = *(const LAS v4u*)(lds + SG_VT + t * SG_MSTRIDE + d8 * 16); const float bs = sgub[g * 128 + t];
        v4u o;
#pragma unroll
        for (int k = 0; k < 4; ++k) o[k] = pk2(bflo(uu[k]) * (bflo(mm[k]) + bs) * bflo(gg[k]), bfhi(uu[k]) * (bfhi(mm[k]) + bs) * bfhi(gg[k]));
        *(v4u*)(U + off) = o; }
    __syncthreads();
}


#ifdef CHECK
#ifndef CHK_TOL
#define CHK_TOL 0.06f
#endif
constexpr size_t WS_CHK = 250 * MiB;
__device__ __forceinline__ unsigned hsh(unsigned x) { x ^= x >> 16; x *= 0x7feb352du; x ^= x >> 15; x *= 0x846ca68bu; x ^= x >> 16; return x; }
__device__ __forceinline__ float bfv(const bf16* p) { return __uint_as_float((unsigned)(*p) << 16); }
__device__ __forceinline__ float wdot(const bf16* a, const bf16* b, int n, int lane) { float s = 0.f;
    for (int k = lane * 8; k < n; k += 512) { const v4u x = *(const v4u*)(a + k), y = *(const v4u*)(b + k);
#pragma unroll
        for (int e = 0; e < 4; ++e) s += bflo(x[e]) * bflo(y[e]) + bfhi(x[e]) * bfhi(y[e]); }
    return wave_sum(s); }
__device__ __forceinline__ float wave_max(float v) { v = fmaxf(v, pg8::swz_xor<1>(v)); v = fmaxf(v, pg8::swz_xor<2>(v)); v = fmaxf(v, pg8::swz_xor<4>(v)); v = fmaxf(v, pg8::swz_xor<8>(v)); v = fmaxf(v, pg8::swz_xor<16>(v));
    auto rr = __builtin_amdgcn_permlane32_swap(__float_as_uint(v), __float_as_uint(v), false, false); return fmaxf(__uint_as_float(rr[0]), __uint_as_float(rr[1])); }
__device__ __forceinline__ void chk_put(unsigned* chk, int k, float got, float want, float tol_abs) { float e = fabsf(got - want) / (fabsf(want) + tol_abs); if (!(e == e)) e = 1e9f; e = wave_max(e); atomicMax(chk + k, __float_as_uint(e)); }
#define CHKPTR ((unsigned*)(GAS unsigned*)(ldp(PT, 18) + WS_CHK))
#endif
struct Args { const float* in[17]; const int* pos; float* out; unsigned char* ws; };
__global__ void __launch_bounds__(NWAVES * 64, 2) fwd_megakernel(Args args) {
    extern __shared__ __attribute__((aligned(16))) unsigned char lds[];
    cg::grid_group grid = cg::this_grid();
    Frame F; F.lds = (LAS unsigned char*)lds; F.tid = threadIdx.x; F.lane = F.tid & 63; F.wave = __builtin_amdgcn_readfirstlane(F.tid >> 6);
    F.G = gridDim.x; { const int bx = blockIdx.x; F.vcu = (F.G % 8 == 0) ? (bx % 8) * (F.G / 8) + bx / 8 : bx; }
    LAS unsigned long long* PT = (LAS unsigned long long*)(F.lds + 131072 + 1024);
    if (F.tid < 4) ((LAS unsigned*)(F.lds + 131072 + 512))[F.tid] = 0u;
    if (F.tid == 0) {
#define PTSET(k) PT[k] = (unsigned long long)args.in[k]
        PTSET(0); PTSET(1); PTSET(2); PTSET(3); PTSET(4); PTSET(5); PTSET(6); PTSET(7); PTSET(8); PTSET(9); PTSET(10); PTSET(11); PTSET(12); PTSET(13); PTSET(14); PTSET(15); PTSET(16);
#undef PTSET
        PT[17] = (unsigned long long)args.out; PT[18] = (unsigned long long)args.ws; }
    __syncthreads();
    int n_stamp = 0; (void)n_stamp;
    { XcdBarrier xb0 = xcd_barrier_post((unsigned*)(GAS unsigned*)(ldp(PT, 18) + WS_BAR), (volatile LAS unsigned*)(F.lds + 131072 + 512));
      if (F.tid == 0) ((volatile LAS unsigned*)(F.lds + 131072 + 512))[2] = xb0.x; }
#define GRID_SYNC_CG() do { asm volatile("s_waitcnt vmcnt(0) lgkmcnt(0)" ::: "memory"); grid.sync(); if (F.wave == 0) asm volatile("buffer_inv sc1\n\ts_waitcnt vmcnt(0)" ::: "memory"); __syncthreads(); STAMP(); } while (0)
#ifdef ALL_CG_SYNC
#define GRID_SYNC() GRID_SYNC_CG()
#else
#define GRID_SYNC() do { XcdBarrier xb_; xb_.st = (volatile LAS unsigned*)(F.lds + 131072 + 512); xb_.bar = (unsigned*)(GAS unsigned*)(ldp(PT, 18) + WS_BAR); xb_.x = (threadIdx.x == 0) ? xb_.st[2] : 0u; xcd_barrier(xb_); STAMP(); } while (0)
#endif
#ifdef TIMING
#define STAMP() do { if (blockIdx.x == 0 && threadIdx.x == 0) { ((unsigned long long*)((GAS unsigned char*)ldp(PT, 18) + 252 * MiB))[n_stamp] = __builtin_amdgcn_s_memrealtime(); } ++n_stamp; } while (0)
#else
#define STAMP() do { } while (0)
#endif
#define REFRESH() do { int t_ = threadIdx.x; asm volatile("" : "+v"(t_)); F.tid = t_; F.lane = t_ & 63; } while (0)
#define PIN(k) ((const float*)(const GAS float*)ldp(PT, k))
#define POUT ((float*)(GAS float*)ldp(PT, 17))
#define WSB(off) ((bf16*)(GAS bf16*)(ldp(PT, 18) + (off)))
#define WSF(off) ((float*)(GAS float*)(ldp(PT, 18) + (off)))
    const int gw = F.vcu * NWAVES + F.wave, NGW = F.G * NWAVES;
    LAS float* scr = (LAS float*)(F.lds + F.wave * 16384);

    if (F.G == 0x7fffffff) grid.sync();
    {
        REFRESH();
        const float *x = PIN(0), *pre_norm = PIN(2), *w_in = PIN(4), *w_out = PIN(5), *pool_w = PIN(6), *sgu_w = PIN(15); const int* pos = (const int*)PIN(1);
        bf16 *Win_t = WSB(WS_WIN), *Wout_t = WSB(WS_WOUT), *Wout1_t = WSB(WS_WOUT1), *Poolw_t = WSB(WS_POOLW), *Sguw = WSB(WS_SGUW), *XN = WSB(WS_XN); float* rope = WSF(WS_ROPE);
        constexpr int I_IN = (DMODEL / 64) * (INCOLS / 32), I_OUT = (DIN / 64) * (DMODEL / 32), I_PW = (256 / 64) * (256 / 32);
        for (int it = gw; it < I_IN + 2 * I_OUT + 4 * I_PW; it += NGW) { int r = it;
            if (r < I_IN) { p0_transpose_item(w_in, DMODEL, INCOLS, Win_t, 0, scr, r, F.lane); continue; } r -= I_IN;
            if (r < I_OUT) { p0_transpose_item(w_out, DIN, DMODEL, Wout_t, 0, scr, r, F.lane); continue; } r -= I_OUT;
            if (r < I_OUT) { p0_transpose_item(w_out + (size_t)DIN * DMODEL, DIN, DMODEL, Wout1_t, 0, scr, r, F.lane); continue; } r -= I_OUT;
            const int gq = r / I_PW; p0_transpose_item(pool_w + (size_t)gq * 65536, 256, 256, Poolw_t, gq * 256, scr, r % I_PW, F.lane); }
        for (int i = blockIdx.x * 512 + F.tid; i < M * 8; i += F.G * 512) { const int row = i >> 3, k = i & 7;
            const float inv = __powf(500000.0f, -(float)k * 0.125f); const float ang = (float)pos[row] * inv; float sn, cs; sincosf(ang, &sn, &cs);
            rope[(size_t)row * 16 + k] = cs; rope[(size_t)row * 16 + 8 + k] = sn; }
        for (int i = blockIdx.x * 512 + F.tid; i < 8 * 128 * 128; i += F.G * 512) { const int s = i & 127, t = (i >> 7) & 127; Sguw[i] = (bf16)((s <= t) ? f2bf(sgu_w[i]) : 0u); }
        for (int m = gw; m < M; m += NGW) rms_row_to_bf16(x + (size_t)m * DMODEL, pre_norm, XN + (size_t)m * DMODEL, F.lane);
    }
    GRID_SYNC();
    {
        bf16 *XN = WSB(WS_XN), *Win_t = WSB(WS_WIN), *Abuf = WSB(WS_A), *G0 = (bf16*)POUT; float* rope = WSF(WS_ROPE);
        pg8::Gemm g{XN, Win_t, M, INCOLS, DMODEL, DMODEL, DMODEL, 0}; pg8::StaticOrder S; S.init(M, INCOLS, F.G, (int)blockIdx.x);
        pg8::EpiProj0 E{Abuf, G0, (size_t)(WS_Q - WS_A) / 2, rope, attn_body::C2};
        pg8::gemm_phase<pg8::EpiProj0, pg8::StaticOrder, true, true>(F.lds, g, S, E);
    }
    GRID_SYNC();
    {
        REFRESH();
        { const float* w_in = PIN(4); bf16* Win_t = WSB(WS_WIN); constexpr int I_IN = (DMODEL / 64) * (INCOLS / 32);
          for (int it = gw; it < I_IN; it += NGW) p0_transpose_item(w_in + (size_t)DMODEL * INCOLS, DMODEL, INCOLS, Win_t, 0, scr, it, F.lane); }
        { bf16 *Abuf = WSB(WS_A), *XN = WSB(WS_XN);
          for (int task = blockIdx.x * 512 + F.tid; task < M * 128; task += F.G * 512) { const int row = task >> 7, ck = task & 127, gq = ck >> 5, w = 2 << gq, s = row & (SEQ - 1), cnt = (s + 1 < w) ? s + 1 : w;
            float sum[8], a0[8];
#pragma unroll
            for (int k = 0; k < 8; ++k) sum[k] = 0.f;
            for (int j = 0; j < cnt; ++j) { const v4u r = *(const v4u*)(Abuf + (size_t)(row - j) * 1024 + ck * 8);
#pragma unroll
                for (int k = 0; k < 4; ++k) { const float lo = bflo(r[k]), hi = bfhi(r[k]); sum[2 * k] += lo; sum[2 * k + 1] += hi; if (j == 0) { a0[2 * k] = lo; a0[2 * k + 1] = hi; } } }
            const float rc = 1.f / (float)cnt; v4u o;
#pragma unroll
            for (int k = 0; k < 4; ++k) o[k] = pk2(sum[2 * k] * rc - a0[2 * k], sum[2 * k + 1] * rc - a0[2 * k + 1]);
            *(v4u*)(XN + (size_t)row * 1024 + ck * 8) = o; } }
        asm volatile("s_waitcnt vmcnt(0) lgkmcnt(0)" ::: "memory"); __syncthreads();
        bf16 *Qb = WSB(WS_Q), *Kb = WSB(WS_K), *Vb = WSB(WS_V), *Ob = WSB(WS_O);
        const attn_body::AttnTensors AT{(const attn_body::bf16*)Qb, (const attn_body::bf16*)Kb, (const attn_body::bf16*)Vb, (attn_body::bf16*)Ob};
        const attn_body::StaticOrder S((int)F.G, (int)blockIdx.x);
        attn_body::attn_phase<attn_body::StaticOrder, 8>((char*)lds, AT, S);
    }
    GRID_SYNC();
    {
        { const float* pool_scale = PIN(7); bf16 *XN = WSB(WS_XN), *Poolw_t = WSB(WS_POOLW), *Yb = WSB(WS_Y), *G0 = (bf16*)POUT;
          pg8::Gemm g{XN, Poolw_t, M, 1024, 256, 1024, 256, 512}; pg8::StaticOrder S; S.init(M, 1024, F.G, (int)blockIdx.x);
          pg8::EpiPool E{Yb, G0, pool_scale};
          pg8::gemm_phase<pg8::EpiPool, pg8::StaticOrder, true, true>(F.lds, g, S, E); }
        REFRESH();
        const float *lq1 = PIN(8), *lk1 = PIN(9), *lq2 = PIN(10), *lk2 = PIN(11), *subln = PIN(12); bf16 *Ob = WSB(WS_O), *Yb = WSB(WS_Y), *G0 = (bf16*)POUT;
        float lam; { const float a = wave_sum(lq1[F.lane] * lk1[F.lane]), b = wave_sum(lq2[F.lane] * lk2[F.lane]); lam = expf(a) - expf(b) + 0.2f; }
        for (int m = gw; m < M; m += NGW) combine_row(Ob, G0, subln, Yb, m, lam, F.lane);
    }
    GRID_SYNC();
    {
        bf16 *Yb = WSB(WS_Y), *Wout_t = WSB(WS_WOUT); float* out0 = WSF(WS_OUT0);
        pg8::Gemm g{Yb, Wout_t, M, DMODEL, DIN, DIN, DIN, 0}; pg8::StaticOrder S; S.init(M, DMODEL, F.G, (int)blockIdx.x);
        pg8::EpiF32 E{out0, DMODEL};
        pg8::gemm_phase<pg8::EpiF32, pg8::StaticOrder, true, true>(F.lds, g, S, E);
    }
    GRID_SYNC();
    {
        REFRESH();
        const float *x = PIN(0), *pre_norm = PIN(2), *post_norm = PIN(3); float *out = POUT, *out0 = WSF(WS_OUT0); bf16* Abuf = WSB(WS_A);
        for (int m = gw; m < M; m += NGW) post_row<true>(out0 + (size_t)m * DMODEL, x + (size_t)m * DMODEL, post_norm, out + (size_t)m * DMODEL, pre_norm + DMODEL, Abuf + (size_t)m * DMODEL, F.lane);
    }
    GRID_SYNC();
    {
        bf16 *Abuf = WSB(WS_A), *Win_t = WSB(WS_WIN), *Ub = WSB(WS_U); float* stats = WSF(WS_STATS);
        pg8::Gemm g{Abuf, Win_t, M, INCOLS, DMODEL, DMODEL, DMODEL, 0}; pg8::StaticOrder S; S.init(M, INCOLS, F.G, (int)blockIdx.x);
        pg8::EpiProj1 E{Ub, (size_t)(WS_V1 - WS_U) / 2, stats};
        pg8::gemm_phase<pg8::EpiProj1, pg8::StaticOrder, true, true>(F.lds, g, S, E);
    }
    GRID_SYNC();
    { REFRESH(); const float *ln_g = PIN(13), *ln_b = PIN(14), *sgu_b = PIN(16); bf16 *Ub = WSB(WS_U), *V1b = WSB(WS_V1), *G1b = WSB(WS_G1), *Sguw = WSB(WS_SGUW); float* stats = WSF(WS_STATS);
      for (int un = F.vcu; un < 128 * 8; un += F.G) sgu_unit(F, un >> 3, un & 7, Ub, V1b, G1b, stats, Sguw, ln_g, ln_b, sgu_b); }
    GRID_SYNC();
    {
        bf16 *Ub = WSB(WS_U), *Wout1_t = WSB(WS_WOUT1); float* out1 = WSF(WS_OUT1);
        pg8::Gemm g{Ub, Wout1_t, M, DMODEL, DIN, DIN, DIN, 0}; pg8::StaticOrder S; S.init(M, DMODEL, F.G, (int)blockIdx.x);
        pg8::EpiF32 E{out1, DMODEL};
        pg8::gemm_phase<pg8::EpiF32, pg8::StaticOrder, true, true>(F.lds, g, S, E);
    }
    GRID_SYNC();
    { REFRESH(); const float* post_norm = PIN(3); float *out = POUT, *out1 = WSF(WS_OUT1);
      for (int m = gw; m < M; m += NGW) post_row<false>(out1 + (size_t)m * DMODEL, out + (size_t)m * DMODEL, post_norm + DMODEL, out + (size_t)m * DMODEL, nullptr, nullptr, F.lane); }
}

extern "C" void kernel_launch(void* const* d_in, const int* in_sizes, int n_in, void* d_out, int out_size, void* d_ws, size_t ws_size, hipStream_t stream) {
    static int grid = 0;
    if (grid == 0) {
        if (n_in != 17 || in_sizes[0] != M * DMODEL || out_size != M * DMODEL || ws_size < WS_END) { fprintf(stderr, "kernel_launch: unexpected shapes (n_in %d, ws %zu)\n", n_in, ws_size); grid = -1; return; }
        int dev = 0, cus = 0, per_cu = 0;
        hipGetDevice(&dev); hipDeviceGetAttribute(&cus, hipDeviceAttributeMultiprocessorCount, dev);
        if (hipFuncSetAttribute((const void*)fwd_megakernel, hipFuncAttributeMaxDynamicSharedMemorySize, LDS_BYTES) != hipSuccess) { fprintf(stderr, "kernel_launch: hipFuncSetAttribute failed\n"); grid = -1; return; }
        if (hipOccupancyMaxActiveBlocksPerMultiprocessor(&per_cu, (const void*)fwd_megakernel, NWAVES * 64, LDS_BYTES) != hipSuccess || per_cu < 1) { fprintf(stderr, "kernel_launch: occupancy query says %d\n", per_cu); per_cu = 1; }
        (void)hipGetLastError();
        grid = cus * 1;
    }
    if (grid < 0) return;
    if (hipMemsetAsync(d_ws, 0, 65536, stream) != hipSuccess) { fprintf(stderr, "kernel_launch: memset of the barrier words failed\n"); return; }
    Args a{};
    for (int i = 0; i < 17; ++i) a.in[i] = (const float*)d_in[i];
    a.pos = (const int*)d_in[1]; a.out = (float*)d_out; a.ws = (unsigned char*)d_ws;
    void* kargs[] = {&a};
    hipError_t e = hipLaunchCooperativeKernel((const void*)fwd_megakernel, dim3(grid), dim3(NWAVES * 64), kargs, LDS_BYTES, stream);
    if (e != hipSuccess) fprintf(stderr, "cooperative launch failed: %s (grid %d)\n", hipGetErrorString(e), grid);
}
```

```cpp
#include <hip/hip_runtime.h>
#include <hip/hip_cooperative_groups.h>
#include <cstdio>
#include <cstdint>

namespace pg8 {
#define PG8_LAS __attribute__((address_space(3)))
typedef unsigned short bf16_t;
typedef short bf16x8 __attribute__((ext_vector_type(8)));
typedef float f32x4 __attribute__((ext_vector_type(4)));
typedef unsigned u32x4 __attribute__((ext_vector_type(4)));
constexpr int BM = 256, BK = 64, HALF = 128, HTB = HALF * BK * 2  , STAGE_BYTES = 8 * HTB, NXCD = 8, WGM = 8;

__host__ __device__ __forceinline__ int lds_byte(int r, int c) { const int st = (r >> 4) * 2 + (c >> 5), rr = r & 15, cc = c & 31, ob = rr * 64 + cc * 2; return st * 1024 + (ob ^ (((ob >> 9) & 1) << 5)); }
__host__ __device__ __forceinline__ void stage_rc(int b, int& R, int& C) { const int st = b / 1024, sb = b % 1024, swz = sb ^ (((sb >> 9) & 1) << 5); R = (st >> 1) * 16 + swz / 64; C = (st & 1) * 32 + (swz % 64) / 2; }
__host__ __device__ __forceinline__ int perm32(int rho) { const int n = rho >> 4, i = rho & 15; return 8 * (i >> 2) + 4 * n + (i & 3); }

struct Unit { int pm, pn; };
struct Gemm { const bf16_t* A; const bf16_t* Bt; int M, N, K, lda, ldb, a_pn_bytes; };

struct StaticOrder {
    int nM, nN, nwg, G, c;
    __host__ __device__ void init(int M, int N, int G_, int c_) { nM = M / BM; nN = N / BM; nwg = nM * nN; G = G_; c = c_; }
    __host__ __device__ bool next(int i, Unit& u) const {
        const long L = (long)i * G + c; if (L >= nwg) return false;
        int wgid = (int)L; { const int q = nwg / NXCD, r = nwg % NXCD, xcd = wgid % NXCD, off = wgid / NXCD; wgid = (xcd < r ? xcd * (q + 1) : r * (q + 1) + (xcd - r) * q) + off; }
        const int nig = WGM * nN, gid = wgid / nig, fm = gid * WGM, gsz = (nM - fm) < WGM ? (nM - fm) : WGM;
        u.pm = fm + ((wgid % nig) % gsz); u.pn = (wgid % nig) / gsz; return true;
    }
    __device__ __forceinline__ void a_ready(const Unit&) const {}
    __device__ __forceinline__ void done(const Unit&) const {}
};

typedef float f32x2c_t __attribute__((ext_vector_type(2))); typedef __bf16 bf16x2c_t __attribute__((ext_vector_type(2)));
__device__ __forceinline__ unsigned cvt_pk_bf16(float lo, float hi) { const f32x2c_t v = {lo, hi}; const bf16x2c_t b = __builtin_convertvector(v, bf16x2c_t); return __builtin_bit_cast(unsigned, b); }
__device__ __forceinline__ float silu_f(float x) { return x * __builtin_amdgcn_rcpf(1.0f + __builtin_amdgcn_exp2f(-1.4426950408889634f * x)); }
__device__ __forceinline__ float gelu_tanh_f(float x) { const float z = 0.7978845608028654f * (x + 0.044715f * x * x * x); return x * __builtin_amdgcn_rcpf(1.0f + __builtin_amdgcn_exp2f(-2.8853900817779268f * z)); }
__device__ __forceinline__ u32x4 pack8(const f32x4& v0, const f32x4& v1) { u32x4 w; w.x = cvt_pk_bf16(v0[0], v0[1]); w.y = cvt_pk_bf16(v0[2], v0[3]); w.z = cvt_pk_bf16(v1[0], v1[1]); w.w = cvt_pk_bf16(v1[2], v1[3]); return w; }
template <int X> __device__ __forceinline__ float swz_xor(float v) { return __int_as_float(__builtin_amdgcn_ds_swizzle(__float_as_int(v), (X << 10) | 0x1F)); }
__device__ __forceinline__ float half_sum(float v) { auto rr = __builtin_amdgcn_permlane32_swap(__float_as_uint(v), __float_as_uint(v), false, false); return __uint_as_float(rr[0]) + __uint_as_float(rr[1]); }
__device__ __forceinline__ f32x4 shx16(const f32x4& v) { f32x4 r; r[0] = swz_xor<16>(v[0]); r[1] = swz_xor<16>(v[1]); r[2] = swz_xor<16>(v[2]); r[3] = swz_xor<16>(v[3]); return r; }

struct EpiProj0 {
    static constexpr bool PERM = true, AFTER_DRAIN = false;
    bf16_t *A, *G; size_t rstride; const float* rope; float qscale;
    __device__ __forceinline__ void operator()(const f32x4 (&acc)[2][2][4][2], const Unit& u, int wr, int wc, int fr, int fq) const {
        const int row0 = u.pm * BM + wr * 64 + fr, pn = u.pn, reg = pn >> 2;
        bf16_t* base; int ldc, colt;
        if (reg < 4) { base = A + (size_t)reg * rstride; ldc = 1024; colt = (pn & 3) * 256; } else { base = G; ldc = 2048; colt = (pn - 16) * 256; }
        const int col0 = colt + wc * 32 + 8 * fq;

#ifdef PROBE_ROPE
        const bool rot_tile = false,
#else
        const bool rot_tile = (reg == 1 || reg == 2),
#endif
        rot_lane = ((wc & 1) == 0) && (fq < 2), gate = reg >= 4;
        const float sc = (reg == 1) ? qscale : 1.f, sgn = (fq == 0) ? -1.f : 1.f;
#pragma unroll
        for (int ai = 0; ai < 2; ++ai)
#pragma unroll
            for (int m = 0; m < 4; ++m) { const int row = row0 + ai * HALF + m * 16; bf16_t* rowp = base + (size_t)row * ldc + col0;
                f32x4 c0 = {1.f, 1.f, 1.f, 1.f}, c1 = c0, s0 = {0.f, 0.f, 0.f, 0.f}, s1 = s0;
                if (rot_tile) { const f32x4* rp = (const f32x4*)(rope + (size_t)row * 16); c0 = rp[0]; c1 = rp[1]; s0 = rp[2]; s1 = rp[3]; }
#pragma unroll
                for (int bj = 0; bj < 2; ++bj) { f32x4 v0 = acc[ai][bj][m][0], v1 = acc[ai][bj][m][1];
                    if (rot_tile) { const f32x4 p0 = shx16(v0), p1 = shx16(v1); const f32x4 r0 = v0 * c0 + (p0 * s0) * sgn, r1 = v1 * c1 + (p1 * s1) * sgn; if (rot_lane) { v0 = r0; v1 = r1; } }
                    if (gate) {
#pragma unroll
                        for (int j = 0; j < 4; ++j) { v0[j] = silu_f(v0[j]); v1[j] = silu_f(v1[j]); } }
                    v0 = v0 * sc; v1 = v1 * sc;
                    *(u32x4*)(rowp + bj * HALF) = pack8(v0, v1); } }
    }
};
struct EpiProj1 {
    static constexpr bool PERM = true, AFTER_DRAIN = false;
    bf16_t *U; size_t rstride; float* stats;
    __device__ __forceinline__ void operator()(const f32x4 (&acc)[2][2][4][2], const Unit& u, int wr, int wc, int fr, int fq) const {
        const int row0 = u.pm * BM + wr * 64 + fr, pn = u.pn, reg = pn >> 3;
        bf16_t* base = U + (size_t)reg * rstride; const int col0 = (pn & 7) * 256 + wc * 32 + 8 * fq;
#pragma unroll
        for (int ai = 0; ai < 2; ++ai)
#pragma unroll
            for (int m = 0; m < 4; ++m) { const int row = row0 + ai * HALF + m * 16; bf16_t* rowp = base + (size_t)row * 2048 + col0; float s = 0.f, q = 0.f;
#pragma unroll
                for (int bj = 0; bj < 2; ++bj) { f32x4 v0 = acc[ai][bj][m][0], v1 = acc[ai][bj][m][1];
#pragma unroll
                    for (int j = 0; j < 4; ++j) { if (reg == 2) { v0[j] = silu_f(v0[j]); v1[j] = silu_f(v1[j]); } else { v0[j] = gelu_tanh_f(v0[j]); v1[j] = gelu_tanh_f(v1[j]); } }
                    if (reg == 1) {
#pragma unroll
                        for (int j = 0; j < 4; ++j) { s += v0[j] + v1[j]; q += v0[j] * v0[j] + v1[j] * v1[j]; } }
                    *(u32x4*)(rowp + bj * HALF) = pack8(v0, v1); }
                if (reg == 1) { s += swz_xor<16>(s); s = half_sum(s); q += swz_xor<16>(q); q = half_sum(q);
                    if (fq == 0) { float* sp = stats + ((size_t)row * 32 + (pn - 8) * 4 + wc) * 2; sp[0] = s; sp[1] = q; } } }
    }
};
struct EpiF32 {
    static constexpr bool PERM = true, AFTER_DRAIN = false;
    float* O; int ldc;
    __device__ __forceinline__ void operator()(const f32x4 (&acc)[2][2][4][2], const Unit& u, int wr, int wc, int fr, int fq) const {
        const int row0 = u.pm * BM + wr * 64 + fr, col0 = u.pn * BM + wc * 32 + 8 * fq;
#pragma unroll
        for (int ai = 0; ai < 2; ++ai)
#pragma unroll
            for (int m = 0; m < 4; ++m) { float* rowp = O + (size_t)(row0 + ai * HALF + m * 16) * ldc + col0;
#pragma unroll
                for (int bj = 0; bj < 2; ++bj) { *(f32x4*)(rowp + bj * HALF) = acc[ai][bj][m][0]; *(f32x4*)(rowp + bj * HALF + 4) = acc[ai][bj][m][1]; } }
    }
};
struct EpiPool {
    static constexpr bool PERM = true, AFTER_DRAIN = false;
    bf16_t* Y; const bf16_t* G; const float* scale;
    __device__ __forceinline__ void operator()(const f32x4 (&acc)[2][2][4][2], const Unit& u, int wr, int wc, int fr, int fq) const {
        const int row0 = u.pm * BM + wr * 64 + fr, col0 = u.pn * BM + wc * 32 + 8 * fq;
        f32x4 sv[2][2];
#pragma unroll
        for (int bj = 0; bj < 2; ++bj) { sv[bj][0] = *(const f32x4*)(scale + col0 + bj * HALF); sv[bj][1] = *(const f32x4*)(scale + col0 + bj * HALF + 4); }
#pragma unroll
        for (int ai = 0; ai < 2; ++ai)
#pragma unroll
            for (int m = 0; m < 4; ++m) { const size_t off = (size_t)(row0 + ai * HALF + m * 16) * 2048 + col0;
#pragma unroll
                for (int bj = 0; bj < 2; ++bj) { const u32x4 gw = *(const u32x4*)(G + off + bj * HALF);
                    f32x4 g0, g1; g0[0] = __uint_as_float(gw.x << 16); g0[1] = __uint_as_float(gw.x & 0xffff0000u); g0[2] = __uint_as_float(gw.y << 16); g0[3] = __uint_as_float(gw.y & 0xffff0000u);
                    g1[0] = __uint_as_float(gw.z << 16); g1[1] = __uint_as_float(gw.z & 0xffff0000u); g1[2] = __uint_as_float(gw.w << 16); g1[3] = __uint_as_float(gw.w & 0xffff0000u);
                    const f32x4 v0 = acc[ai][bj][m][0] * sv[bj][0] * g0, v1 = acc[ai][bj][m][1] * sv[bj][1] * g1;
                    *(u32x4*)(Y + off + bj * HALF) = pack8(v0, v1); } }
    }
};

template <class Epi, class Sched, bool ALIGN_EPI = false, bool SP2 = false>
__device__ __forceinline__ void gemm_phase(PG8_LAS unsigned char* lds, const Gemm g, const Sched& S, const Epi& E) {
    int tid_ = threadIdx.x; asm volatile("" : "+v"(tid_));
    const int tid = tid_, wid = __builtin_amdgcn_readfirstlane(tid >> 6), lane = tid & 63, wr = wid >> 2, wc = wid & 3, fr = lane & 15, fq = lane >> 4;
    const int K = g.K, nt = K / BK;
    unsigned voffA[2], voffB[2];
#pragma unroll
    for (int i = 0; i < 2; ++i) { int R, C; stage_rc(tid * 16 + i * 8192, R, C); const int Rb = Epi::PERM ? ((R & ~31) + perm32(R & 31)) : R;
        voffA[i] = (unsigned)(R * g.lda + C) * 2u; voffB[i] = (unsigned)(Rb * g.ldb + C) * 2u; }
    const size_t kstep = (size_t)(BK * 2);
    const size_t hstepA = (size_t)HALF * g.lda * 2, hstepB = (size_t)HALF * g.ldb * 2;
    const size_t tstepA = 2 * hstepA, tstepB = 2 * hstepB, apn = (size_t)g.a_pn_bytes;
    const unsigned ldsw = (unsigned)wid * 1024u;
    const int aoff = lds_byte(wr * 64 + fr, fq * 8), boff = lds_byte(wc * 32 + fr, fq * 8);
#define PG8_SA(b, h) (((b) * 2 + (h)) * HTB)
#define PG8_SB(b, h) ((4 + (b) * 2 + (h)) * HTB)
#define PG8_STAGE(bufoff, gbase, voff) do { _Pragma("unroll") for (int _i = 0; _i < 2; ++_i) \
        __builtin_amdgcn_global_load_lds((const unsigned*)((const char*)(gbase) + (voff)[_i]), (PG8_LAS unsigned*)(lds + (bufoff) + ldsw + _i * 8192), 16, 0, 0); } while (0)
#define PG8_LDA(dst, b, h) do { _Pragma("unroll") for (int m = 0; m < 4; ++m) _Pragma("unroll") for (int k = 0; k < 2; ++k) dst[m][k] = *(const PG8_LAS bf16x8*)(lds + PG8_SA(b, h) + aoff + m * 2048 + k * 1024); } while (0)
#define PG8_LDB(dst, b, h) do { _Pragma("unroll") for (int n = 0; n < 2; ++n) _Pragma("unroll") for (int k = 0; k < 2; ++k) dst[n][k] = *(const PG8_LAS bf16x8*)(lds + PG8_SB(b, h) + boff + n * 2048 + k * 1024); } while (0)
#define PG8_MMA(ai, bj, At, Bt) do { __builtin_amdgcn_s_setprio(1); _Pragma("unroll") for (int m = 0; m < 4; ++m) _Pragma("unroll") for (int n = 0; n < 2; ++n) _Pragma("unroll") for (int k = 0; k < 2; ++k) \
        acc[ai][bj][m][n] = __builtin_amdgcn_mfma_f32_16x16x32_bf16(Bt[n][k], At[m][k], acc[ai][bj][m][n], 0, 0, 0); __builtin_amdgcn_s_setprio(0); } while (0)
#define PG8_WAIT_V(n) asm volatile("s_waitcnt vmcnt(" #n ")" ::: "memory")
#define PG8_WAIT_L(n) asm volatile("s_waitcnt lgkmcnt(" #n ")" ::: "memory")
#define PG8_BAR __builtin_amdgcn_s_barrier()
#define PG8_SCHED __builtin_amdgcn_sched_barrier(0)
    Unit cur, nxt; int ui = 0;
    if (!S.next(0, cur)) return;
    f32x4 acc[2][2][4][2];
#pragma unroll
    for (int a = 0; a < 2; ++a)
#pragma unroll
        for (int b = 0; b < 2; ++b)
#pragma unroll
            for (int m = 0; m < 4; ++m)
#pragma unroll
                for (int n = 0; n < 2; ++n) acc[a][b][m][n] = (f32x4){0.f, 0.f, 0.f, 0.f};
    bf16x8 At[4][2], B0[2][2], B1[2][2];
    const char* cA = (const char*)g.A + (size_t)cur.pm * tstepA + (size_t)cur.pn * apn; const char* cB = (const char*)g.Bt + (size_t)cur.pn * tstepB;
    S.a_ready(cur);
    if constexpr (SP2) {
        PG8_STAGE(PG8_SB(0, 0), cB, voffB); PG8_STAGE(PG8_SB(0, 1), cB + hstepB, voffB); PG8_STAGE(PG8_SA(0, 0), cA, voffA); PG8_STAGE(PG8_SA(0, 1), cA + hstepA, voffA);
        if (wr == 1) PG8_BAR;
        PG8_WAIT_V(2); PG8_BAR;
        PG8_STAGE(PG8_SB(1, 0), cB + kstep, voffB); PG8_STAGE(PG8_SA(1, 0), cA + kstep, voffA); PG8_STAGE(PG8_SB(1, 1), cB + hstepB + kstep, voffB);
        PG8_WAIT_V(6); PG8_BAR;
    } else {
        PG8_STAGE(PG8_SB(0, 0), cB, voffB); PG8_STAGE(PG8_SA(0, 0), cA, voffA); PG8_STAGE(PG8_SB(0, 1), cB + hstepB, voffB); PG8_STAGE(PG8_SA(0, 1), cA + hstepA, voffA);
        if (wr == 1) PG8_BAR;
        PG8_WAIT_V(4); PG8_BAR;
        PG8_STAGE(PG8_SB(1, 0), cB + kstep, voffB); PG8_STAGE(PG8_SA(1, 0), cA + kstep, voffA); PG8_STAGE(PG8_SB(1, 1), cB + hstepB + kstep, voffB);
        PG8_WAIT_V(6); PG8_BAR;
    }
    for (;;) {
        const bool has_next = S.next(ui + 1, nxt);
        const char* nA = has_next ? (const char*)g.A + (size_t)nxt.pm * tstepA + (size_t)nxt.pn * apn : cA; const char* nB = has_next ? (const char*)g.Bt + (size_t)nxt.pn * tstepB : cB;
        for (int t = 0; t < nt; t += 2) {
            const bool last = (t == nt - 2);
            const char* a1 = cA + (size_t)(t + 1) * kstep;
            const char* a2 = last ? nA : cA + (size_t)(t + 2) * kstep; const char* b2 = last ? nB : cB + (size_t)(t + 2) * kstep;
            const char* a3 = a2 + kstep; const char* b3 = b2 + kstep;
            if (last && has_next) S.a_ready(nxt);
            if constexpr (SP2) {
            PG8_LDB(B0, 0, 0); PG8_LDB(B1, 0, 1); PG8_SCHED; PG8_LDA(At, 0, 0); PG8_STAGE(PG8_SA(1, 1), a1 + hstepA, voffA);
            PG8_WAIT_V(8); PG8_WAIT_L(0); PG8_BAR; PG8_MMA(0, 0, At, B0); PG8_MMA(0, 1, At, B1); PG8_BAR; PG8_SCHED;
            PG8_LDA(At, 0, 1); PG8_STAGE(PG8_SB(0, 0), b2, voffB); PG8_STAGE(PG8_SB(0, 1), b2 + hstepB, voffB); PG8_STAGE(PG8_SA(0, 0), a2, voffA);
            PG8_WAIT_V(8); PG8_WAIT_L(0); PG8_BAR; PG8_MMA(1, 0, At, B0); PG8_MMA(1, 1, At, B1); PG8_BAR; PG8_SCHED;
            PG8_LDB(B0, 1, 0); PG8_LDB(B1, 1, 1); PG8_SCHED; PG8_LDA(At, 1, 0); PG8_STAGE(PG8_SA(0, 1), a2 + hstepA, voffA);
            PG8_WAIT_V(8); PG8_WAIT_L(0); PG8_BAR; PG8_MMA(0, 0, At, B0); PG8_MMA(0, 1, At, B1); PG8_BAR; PG8_SCHED;
            PG8_LDA(At, 1, 1); PG8_STAGE(PG8_SB(1, 0), b3, voffB); PG8_STAGE(PG8_SB(1, 1), b3 + hstepB, voffB); PG8_STAGE(PG8_SA(1, 0), a3, voffA);
            PG8_WAIT_V(8); PG8_WAIT_L(0); PG8_BAR; PG8_MMA(1, 0, At, B0); PG8_MMA(1, 1, At, B1); PG8_BAR; PG8_SCHED;
            } else {
            PG8_LDB(B0, 0, 0); PG8_SCHED; PG8_LDA(At, 0, 0); PG8_STAGE(PG8_SA(1, 1), a1 + hstepA, voffA);
            PG8_WAIT_L(8); PG8_BAR; PG8_WAIT_L(0); PG8_MMA(0, 0, At, B0); PG8_BAR; PG8_SCHED;
            PG8_LDB(B1, 0, 1); PG8_STAGE(PG8_SB(0, 0), b2, voffB);
            PG8_BAR; PG8_WAIT_L(0); PG8_MMA(0, 1, At, B1); PG8_BAR;
            PG8_LDA(At, 0, 1); PG8_STAGE(PG8_SA(0, 0), a2, voffA);
            PG8_BAR; PG8_WAIT_L(0); PG8_MMA(1, 0, At, B0); PG8_BAR; PG8_SCHED;
            PG8_STAGE(PG8_SB(0, 1), b2 + hstepB, voffB);
            PG8_WAIT_V(6); PG8_BAR; PG8_MMA(1, 1, At, B1); PG8_BAR;
            PG8_LDB(B0, 1, 0); PG8_SCHED; PG8_LDA(At, 1, 0); PG8_STAGE(PG8_SA(0, 1), a2 + hstepA, voffA);
            PG8_WAIT_L(8); PG8_BAR; PG8_WAIT_L(0); PG8_MMA(0, 0, At, B0); PG8_BAR; PG8_SCHED;
            PG8_LDB(B1, 1, 1); PG8_STAGE(PG8_SB(1, 0), b3, voffB);
            PG8_BAR; PG8_WAIT_L(0); PG8_MMA(0, 1, At, B1); PG8_BAR;
            PG8_LDA(At, 1, 1); PG8_STAGE(PG8_SA(1, 0), a3, voffA);
            PG8_BAR; PG8_WAIT_L(0); PG8_MMA(1, 0, At, B0); PG8_BAR; PG8_SCHED;
            PG8_STAGE(PG8_SB(1, 1), b3 + hstepB, voffB);
            PG8_WAIT_V(6); PG8_BAR; PG8_MMA(1, 1, At, B1); PG8_BAR;
            }
        }
        if constexpr (ALIGN_EPI) { if (wr == 0) PG8_BAR; }
        if constexpr (!Epi::AFTER_DRAIN) { E(acc, cur, wr, wc, fr, fq); S.done(cur); }
        if (!has_next) break;
#pragma unroll
        for (int a = 0; a < 2; ++a)
#pragma unroll
            for (int b = 0; b < 2; ++b)
#pragma unroll
                for (int m = 0; m < 4; ++m)
#pragma unroll
                    for (int n = 0; n < 2; ++n) acc[a][b][m][n] = (f32x4){0.f, 0.f, 0.f, 0.f};
        cur = nxt; cA = nA; cB = nB; ++ui;
        if constexpr (ALIGN_EPI) { if (wr == 1) PG8_BAR; }
    }
    PG8_WAIT_V(0);
    if constexpr (!ALIGN_EPI) { if (wr == 0) PG8_BAR; }
    PG8_BAR;
    if constexpr (Epi::AFTER_DRAIN) { E.fused(acc, cur, wr, wc, fr, fq, lds, wid, lane); S.done(cur); }
#undef PG8_SA
#undef PG8_SB
#undef PG8_STAGE
#undef PG8_LDA
#undef PG8_LDB
#undef PG8_MMA
#undef PG8_WAIT_V
#undef PG8_WAIT_L
#undef PG8_BAR
#undef PG8_SCHED
}
}
#include <hip/hip_bf16.h>
#include <cmath>
namespace attn_body {
using bf16=__hip_bfloat16;
using bf16x8=__attribute__((ext_vector_type(8)))short;
using s16x4=__attribute__((ext_vector_type(4)))short;
using f32x16=__attribute__((ext_vector_type(16)))float;
using u32x4=__attribute__((ext_vector_type(4)))unsigned;
constexpr int BATCH=4,NHEAD=32,SEQ=4096,D=64,PQ=1024,PO=2048;
constexpr int NW=8,QBLK=32,QB=QBLK*NW,KVBLK=64,NQB=SEQ/QB;
constexpr int ATTN_UNIT_ROWS=QB;
__device__ __forceinline__ int crow(int r,int hi){return (r&3)+8*(r>>2)+4*hi;}
#define SBAR() __builtin_amdgcn_sched_barrier(0)
__device__ __forceinline__ void cmask(f32x16&p0,f32x16&p1,int jb,int qrel,int hi){
  const float NEG=-INFINITY; int kb=64*jb+4*hi;
  #pragma unroll
  for(int r=0;r<16;++r){int kv=kb+(r&3)+8*(r>>2); if(kv>qrel)p0[r]=NEG; if(kv+32>qrel)p1[r]=NEG;}
}

constexpr int NSLOT=3, SLOTB=8192;
constexpr int LDS_K=0, LDS_V=NSLOT*SLOTB, LDS_WS=2*NSLOT*SLOTB, LDS_OST=LDS_WS+NW*64*4, LDS_BYTES=LDS_OST+NW*4096;
constexpr float C2=0.125f*1.4426950408889634f;
__device__ __forceinline__ void glds16(const void*gsrc,unsigned lds_dst){unsigned keep;
  asm volatile("s_mov_b32 %0, m0\n\ts_mov_b32 m0, %2\n\ts_nop 0\n\tglobal_load_lds_dwordx4 %1, off\n\ts_mov_b32 m0, %0":"=&s"(keep):"v"(gsrc),"s"(lds_dst):"memory");}
__device__ __forceinline__ float max3f(float a,float b,float c){float r;asm("v_max3_f32 %0, %1, %2, %3":"=v"(r):"v"(a),"v"(b),"v"(c));return r;}
__device__ __forceinline__ float max2f(float a,float b){float r;asm("v_max_f32_e32 %0, %1, %2":"=v"(r):"v"(a),"v"(b));return r;}
__device__ __forceinline__ float fadd_s(float a,float b){float r;asm("v_add_f32_e32 %0, %1, %2":"=v"(r):"v"(a),"v"(b));return r;}
__device__ __forceinline__ float fsub_s(float a,float b){float r;asm("v_sub_f32_e32 %0, %1, %2":"=v"(r):"v"(a),"v"(b));return r;}
typedef float f32x2_t __attribute__((ext_vector_type(2))); typedef __bf16 bf16x2_t __attribute__((ext_vector_type(2)));
__device__ __forceinline__ unsigned cvtpk_s(float lo,float hi){f32x2_t v={lo,hi};bf16x2_t b=__builtin_convertvector(v,bf16x2_t);return __builtin_bit_cast(unsigned,b);}
#define WAIT_BAR(N) asm volatile("s_waitcnt vmcnt(" #N ") lgkmcnt(0)\n\ts_barrier":::"memory")

__device__ __forceinline__ void qkt(f32x16&p0,f32x16&p1,const char*Kslot,const bf16x8*qr,const f32x16&negm,int r32,int hi){
  const char*kb=Kslot+hi*1024+r32*16;
  #pragma unroll
  for(int d0=0;d0<4;++d0){
    const bf16x8 b0=*reinterpret_cast<const bf16x8*>(kb+d0*2048);
    const bf16x8 b1=*reinterpret_cast<const bf16x8*>(kb+d0*2048+512);
    if(d0==0){p0=__builtin_amdgcn_mfma_f32_32x32x16_bf16(b0,qr[0],negm,0,0,0);p1=__builtin_amdgcn_mfma_f32_32x32x16_bf16(b1,qr[0],negm,0,0,0);}
    else{p0=__builtin_amdgcn_mfma_f32_32x32x16_bf16(b0,qr[d0],p0,0,0,0);p1=__builtin_amdgcn_mfma_f32_32x32x16_bf16(b1,qr[d0],p1,0,0,0);}}
}
typedef __attribute__((address_space(3))) const char* lds_cptr;
typedef short v4i16_t __attribute__((ext_vector_type(4)));
__device__ __forceinline__ void kload8(bf16x8*kf,lds_cptr kp){
  kf[0]=*(const __attribute__((address_space(3))) bf16x8*)(kp);      kf[1]=*(const __attribute__((address_space(3))) bf16x8*)(kp+512);
  kf[2]=*(const __attribute__((address_space(3))) bf16x8*)(kp+2048); kf[3]=*(const __attribute__((address_space(3))) bf16x8*)(kp+2560);
  kf[4]=*(const __attribute__((address_space(3))) bf16x8*)(kp+4096); kf[5]=*(const __attribute__((address_space(3))) bf16x8*)(kp+4608);
  kf[6]=*(const __attribute__((address_space(3))) bf16x8*)(kp+6144); kf[7]=*(const __attribute__((address_space(3))) bf16x8*)(kp+6656);
}
__device__ __forceinline__ void kload2(bf16x8*kf,lds_cptr kp,int j){ kf[2*j]=*(const __attribute__((address_space(3))) bf16x8*)(kp+j*2048); kf[2*j+1]=*(const __attribute__((address_space(3))) bf16x8*)(kp+j*2048+512); }
__device__ __forceinline__ s16x4 vtr(lds_cptr p){ return __builtin_bit_cast(s16x4,__builtin_amdgcn_ds_read_tr16_b64_v4i16((__attribute__((address_space(3))) v4i16_t*)p)); }
__device__ __forceinline__ float rowmax(const f32x16&p0,const f32x16&p1){
  float a=max3f(p0[0],p0[1],p1[0]),b=max3f(p0[2],p0[3],p1[1]);a=max3f(a,p1[2],p1[3]);
  #pragma unroll
  for(int r=4;r<16;r+=4){a=max3f(a,p0[r],p0[r+1]);b=max3f(b,p0[r+2],p0[r+3]);a=max3f(a,p1[r],p1[r+1]);b=max3f(b,p1[r+2],p1[r+3]);}
  const float m=max2f(a,b);
  auto rr=__builtin_amdgcn_permlane32_swap(__float_as_uint(m),__float_as_uint(m),false,false);
  return max2f(__uint_as_float(rr[0]),__uint_as_float(rr[1]));
}
__device__ __forceinline__ void pv(f32x16*o,int vb,bf16x8 pa0,bf16x8 pa1,bf16x8 pa2,bf16x8 pa3){
  #pragma unroll
  for(int d0=0;d0<2;++d0){s16x4 lo[4],hi[4];
    #pragma unroll
    for(int ks=0;ks<4;++ks){
      asm volatile("ds_read_b64_tr_b16 %0,%1 offset:%c2":"=&v"(lo[ks]):"v"(vb),"i"(d0*4096+ks*1024):"memory");
      asm volatile("ds_read_b64_tr_b16 %0,%1 offset:%c2":"=&v"(hi[ks]):"v"(vb),"i"(d0*4096+ks*1024+512):"memory");}
    asm volatile("s_waitcnt lgkmcnt(0)":::"memory");SBAR();
    #define PK(k) (bf16x8){lo[k][0],lo[k][1],lo[k][2],lo[k][3],hi[k][0],hi[k][1],hi[k][2],hi[k][3]}
    o[d0]=__builtin_amdgcn_mfma_f32_32x32x16_bf16(pa0,PK(0),o[d0],0,0,0);
    o[d0]=__builtin_amdgcn_mfma_f32_32x32x16_bf16(pa1,PK(1),o[d0],0,0,0);
    o[d0]=__builtin_amdgcn_mfma_f32_32x32x16_bf16(pa2,PK(2),o[d0],0,0,0);
    o[d0]=__builtin_amdgcn_mfma_f32_32x32x16_bf16(pa3,PK(3),o[d0],0,0,0);
    #undef PK
  }
}

#ifndef ATTN_STORE16
#define ATTN_STORE16(p,v) (*(u32x4*)(p)=(v))
#endif
template<int THRL> __device__ __forceinline__ void attn_unit(int b,int vh,int qb,const bf16*Q,const bf16*__restrict__ K,const bf16*__restrict__ V,bf16*O,char*shm){
  int tid_=threadIdx.x; asm volatile("":"+v"(tid_)); const int tid=tid_,lane=tid&63,r32=lane&31,hi=lane>>5; const int wid=__builtin_amdgcn_readfirstlane(tid>>6);
  const long rowbase=(long)b*SEQ; const int q0=qb*QB;
  const int qcol=(vh>>2)*128+((vh>>1)&1)*64, vcol=(vh>>2)*128+(vh&1)*64, ocol=vh*64;
  const bf16*Qw=Q+(rowbase+q0+wid*QBLK)*PQ+qcol;
  const bf16*Kh=K+rowbase*PQ+qcol,*Vh=V+rowbase*PQ+vcol;
  const unsigned lds0=(unsigned)(uintptr_t)shm;
  float*wsf=(float*)(shm+LDS_WS)+wid*64;
  const bf16*ksrc=Kh+(long)lane*PQ+wid*8;
  const bf16*vsrc=Vh+(long)(16*(wid&3)+(lane>>2))*PQ+(wid>>2)*32+(lane&3)*8;
  const unsigned kdst=lds0+LDS_K+wid*1024, vdst=lds0+LDS_V+wid*1024;
  #define DMA_K(t,slot) glds16(ksrc+(long)(t)*KVBLK*PQ,(unsigned)__builtin_amdgcn_readfirstlane(kdst+(slot)))
  #define DMA_V(t,slot) glds16(vsrc+(long)(t)*KVBLK*PQ,(unsigned)__builtin_amdgcn_readfirstlane(vdst+(slot)))
  const int vb0=(int)(lds0+LDS_V)+((lane>>4)&1)*32+(lane&3)*8+(4*hi+((lane&15)>>2))*64;
  const char*Kbase=shm+LDS_K; bf16x8 kf[8];
  const lds_cptr shm3=(lds_cptr)shm; const lds_cptr kp0=shm3+LDS_K+hi*1024+r32*16; const lds_cptr vp0=shm3+LDS_V+((lane>>4)&1)*32+(lane&3)*8+(4*hi+((lane&15)>>2))*64;
  const int NT=(q0+QB)/KVBLK;
  DMA_K(0,0);DMA_V(0,0);DMA_K(1,SLOTB);
  bf16x8 qr[4];
  #pragma unroll
  for(int d0=0;d0<4;++d0)qr[d0]=*reinterpret_cast<const bf16x8*>(&Qw[(long)r32*PQ+d0*16+hi*8]);
  float mhat=0.f,l_reg=0.f;f32x16 o[2];o[0]=f32x16{};o[1]=f32x16{};f32x16 negm=f32x16{};asm volatile("":"+v"(negm));
  const int qrel=wid*QBLK+r32;
  #define CMASK(P0,P1,t) do{int jb_=(t)-(NT-4); if(jb_>=0)cmask(P0,P1,jb_,qrel,hi);}while(0)
  bool resc=false;
  #define START(P0,P1) do{ const float rm=rowmax(P0,P1); resc=false; \
    { const float dl=rm; mhat=fadd_s(mhat,dl); \
      _Pragma("unroll") for(int r=0;r<16;++r){P0[r]=fsub_s(P0[r],dl);P1[r]=fsub_s(P1[r],dl);} \
      _Pragma("unroll") for(int r=0;r<16;++r)negm[r]=-mhat; asm volatile("":"+v"(negm)); } \
    _Pragma("unroll") for(int r=0;r<16;++r)P0[r]=__builtin_amdgcn_exp2f(P0[r]); }while(0)
  #define RESC() do{ if(resc){ asm volatile("s_waitcnt lgkmcnt(0)":::"memory"); \
      _Pragma("unroll") for(int d_=0;d_<2;++d_) _Pragma("unroll") for(int r=0;r<16;++r)o[d_][r]*=wsf[crow(r,hi)]; } }while(0)
  f32x16 pA0,pA1,pB0,pB1;
  int sl_prev=0,sl_cur=0,sl_next=SLOTB;
  #define ROT() do{sl_prev=sl_cur;sl_cur=sl_next;sl_next=(sl_next==(NSLOT-1)*SLOTB)?0:sl_next+SLOTB;}while(0)
  DMA_K(2,2*SLOTB);
  WAIT_BAR(3);
  qkt(pA0,pA1,Kbase,qr,negm,r32,hi);asm volatile("s_nop 15\n\ts_nop 7":"+v"(pA0),"+v"(pA1));CMASK(pA0,pA1,0);
  START(pA0,pA1);
  _Pragma("unroll") for(int r=0;r<16;++r)pA1[r]=__builtin_amdgcn_exp2f(pA1[r]);
  WAIT_BAR(0);
  DMA_K(3,0);DMA_V(1,SLOTB);
  ROT();
  kload8(kf,kp0+sl_cur);
  WAIT_BAR(2);
  s16x4 vlo[8],vhi[8]; u32x4 pw0,pw1,pw2,pw3;
  #define PKW(P,B) cvtpk_s(P[B],P[B+1])
  #define PAF(k) __builtin_bit_cast(bf16x8,pw##k)
  #define VFR(i) (bf16x8){vlo[i][0],vlo[i][1],vlo[i][2],vlo[i][3],vhi[i][0],vhi[i][1],vhi[i][2],vhi[i][3]}
  #define PIN(x) asm volatile("":"+v"(x))
  #define MX3(a,b,c) __builtin_fmaxf(__builtin_fmaxf((a),(b)),(c))
  #define GAPA(MF,A0,A1,A2,A3,W0,W1,PW) do{ MF; sacc+=A0; sacc+=A1; sacc+=A2; sacc+=A3; PIN(sacc); W0; W1; PIN(PW); SBAR(); }while(0)
  #define EX(v) __builtin_amdgcn_exp2f(v)
  #define GAPB(MF,X,B) do{ MF; X[B]=EX(X[B]); X[B+1]=EX(X[B+1]); X[B+2]=EX(X[B+2]); X[B+3]=EX(X[B+3]); PIN(X); SBAR(); }while(0)
  #define VRD(i) do{ vlo[i]=vtr(vp_+(((i)>>2)*4096+((i)&3)*1024)); vhi[i]=vtr(vp_+(((i)>>2)*4096+((i)&3)*1024+512)); }while(0)
  #define KRD(G,j) do{ if(G){ kload2(kf,kp0+sl_next,j); SBAR(); } }while(0)
  #define STEP(C0,C1,P0,P1,t,GK,GV,GL) do{ SBAR(); \
    const lds_cptr vp_=vp0+sl_prev; \
    VRD(0); SBAR(); float sacc=(P0[0]+P0[1]); \
    GAPA(C0=__builtin_amdgcn_mfma_f32_32x32x16_bf16(kf[0],qr[0],negm,0,0,0), P0[2],P0[3],P0[4],P0[5],     pw0[0]=PKW(P0,0), pw0[1]=PKW(P0,2), pw0); \
    VRD(4); SBAR(); GAPA(C1=__builtin_amdgcn_mfma_f32_32x32x16_bf16(kf[1],qr[0],negm,0,0,0), P0[6],P0[7],P0[8],P0[9],     pw0[2]=PKW(P0,4), pw0[3]=PKW(P0,6), pw0); \
    VRD(1); SBAR(); GAPA(C0=__builtin_amdgcn_mfma_f32_32x32x16_bf16(kf[2],qr[1],C0,0,0,0),   P0[10],P0[11],P0[12],P0[13], pw1[0]=PKW(P0,8), pw1[1]=PKW(P0,10), pw1); \
    VRD(5); SBAR(); GAPA(C1=__builtin_amdgcn_mfma_f32_32x32x16_bf16(kf[3],qr[1],C1,0,0,0),   P0[14],P0[15],P1[0],P1[1],   pw1[2]=PKW(P0,12),pw1[3]=PKW(P0,14), pw1); \
    VRD(2); SBAR(); GAPA(C0=__builtin_amdgcn_mfma_f32_32x32x16_bf16(kf[4],qr[2],C0,0,0,0),   P1[2],P1[3],P1[4],P1[5],     pw2[0]=PKW(P1,0), pw2[1]=PKW(P1,2), pw2); \
    VRD(6); SBAR(); GAPA(C1=__builtin_amdgcn_mfma_f32_32x32x16_bf16(kf[5],qr[2],C1,0,0,0),   P1[6],P1[7],P1[8],P1[9],     pw2[2]=PKW(P1,4), pw2[3]=PKW(P1,6), pw2); \
    VRD(3); SBAR(); GAPA(C0=__builtin_amdgcn_mfma_f32_32x32x16_bf16(kf[6],qr[3],C0,0,0,0),   P1[10],P1[11],P1[12],P1[13], pw3[0]=PKW(P1,8), pw3[1]=PKW(P1,10), pw3); \
    VRD(7); SBAR(); GAPA(C1=__builtin_amdgcn_mfma_f32_32x32x16_bf16(kf[7],qr[3],C1,0,0,0),   P1[14],P1[15],0.f,0.f,       pw3[2]=PKW(P1,12),pw3[3]=PKW(P1,14), pw3); \
    l_reg+=sacc; \
    if(GK){DMA_K((t)+3,sl_cur);} if(GV){DMA_V((t)+1,sl_next);} \
    CMASK(C0,C1,t); \
    { float a=MX3(C0[0],C0[1],C1[0]),b=MX3(C0[2],C0[3],C1[1]); a=MX3(a,C1[2],C1[3]); \
      _Pragma("unroll") for(int r=4;r<16;r+=4){a=MX3(a,C0[r],C0[r+1]);b=MX3(b,C0[r+2],C0[r+3]);a=MX3(a,C1[r],C1[r+1]);b=MX3(b,C1[r+2],C1[r+3]);} \
      float rm=__builtin_fmaxf(a,b); { auto rr=__builtin_amdgcn_permlane32_swap(__float_as_uint(rm),__float_as_uint(rm),false,false); rm=__builtin_fmaxf(__uint_as_float(rr[0]),__uint_as_float(rr[1])); } \
      resc=false; \
      if(__builtin_expect(__any(rm>(float)THRL),0)){ const float dl=__builtin_fmaxf(rm,0.f); mhat+=dl; \
        _Pragma("unroll") for(int r=0;r<16;++r){C0[r]-=dl;C1[r]-=dl;} \
        _Pragma("unroll") for(int r=0;r<16;++r)negm[r]=-mhat; asm volatile("":"+v"(negm)); \
        const float f=__builtin_amdgcn_exp2f(-dl); l_reg*=f; if(hi==0)wsf[r32]=f; resc=true; } } \
    SBAR(); \
    GAPB(o[0]=__builtin_amdgcn_mfma_f32_32x32x16_bf16(PAF(0),VFR(0),o[0],0,0,0), C0,0); \
    GAPB(o[1]=__builtin_amdgcn_mfma_f32_32x32x16_bf16(PAF(0),VFR(4),o[1],0,0,0), C0,4); \
    KRD(GL,0); GAPB(o[0]=__builtin_amdgcn_mfma_f32_32x32x16_bf16(PAF(1),VFR(1),o[0],0,0,0), C0,8); \
    KRD(GL,1); GAPB(o[1]=__builtin_amdgcn_mfma_f32_32x32x16_bf16(PAF(1),VFR(5),o[1],0,0,0), C0,12); \
    KRD(GL,2); GAPB(o[0]=__builtin_amdgcn_mfma_f32_32x32x16_bf16(PAF(2),VFR(2),o[0],0,0,0), C1,0); \
    KRD(GL,3); GAPB(o[1]=__builtin_amdgcn_mfma_f32_32x32x16_bf16(PAF(2),VFR(6),o[1],0,0,0), C1,4); \
    GAPB(o[0]=__builtin_amdgcn_mfma_f32_32x32x16_bf16(PAF(3),VFR(3),o[0],0,0,0), C1,8); \
    GAPB(o[1]=__builtin_amdgcn_mfma_f32_32x32x16_bf16(PAF(3),VFR(7),o[1],0,0,0), C1,12); \
    }while(0)
  int t=1;
  #undef CMASK
  #define CMASK(P0,P1,t) do{}while(0)
  for(;t+5<NT;t+=2){
    STEP(pB0,pB1,pA0,pA1,t,true,true,true);     WAIT_BAR(2); RESC(); ROT();
    STEP(pA0,pA1,pB0,pB1,t+1,true,true,true);   WAIT_BAR(2); RESC(); ROT();
  }
  #undef CMASK
  #define CMASK(P0,P1,t) do{int jb_=(t)-(NT-4); if(jb_>=0)cmask(P0,P1,jb_,qrel,hi);}while(0)
  #define ENDW(tt) do{ if((tt)+3<NT){WAIT_BAR(2);} else if((tt)+2<NT){WAIT_BAR(1);} else {WAIT_BAR(0);} }while(0)
  for(;t+1<NT;t+=2){
    STEP(pB0,pB1,pA0,pA1,t,(t+3<NT),(t+1<NT),(t+1<NT));       ENDW(t);   RESC(); ROT();
    STEP(pA0,pA1,pB0,pB1,t+1,(t+4<NT),(t+2<NT),(t+2<NT));     ENDW(t+1); RESC(); ROT();
  }
  STEP(pB0,pB1,pA0,pA1,NT-1,false,false,false); RESC();
  { float sacc=pB0[0]+pB0[1]; _Pragma("unroll") for(int r=2;r<16;++r)sacc+=pB0[r]; _Pragma("unroll") for(int r=0;r<16;++r)sacc+=pB1[r]; l_reg+=sacc;
    pw0=(u32x4){PKW(pB0,0),PKW(pB0,2),PKW(pB0,4),PKW(pB0,6)};pw1=(u32x4){PKW(pB0,8),PKW(pB0,10),PKW(pB0,12),PKW(pB0,14)};pw2=(u32x4){PKW(pB1,0),PKW(pB1,2),PKW(pB1,4),PKW(pB1,6)};pw3=(u32x4){PKW(pB1,8),PKW(pB1,10),PKW(pB1,12),PKW(pB1,14)};
    SBAR(); pv(o,vb0+sl_cur,PAF(0),PAF(1),PAF(2),PAF(3)); }
  #undef PKW
  #undef PAF
  #undef VFR
  #undef PIN
  #undef MX3
  #undef GAPA
  #undef GAPB
  #undef EX
  #undef VRD
  #undef KRD
  #undef STEP
  #undef ENDW
  {auto rr=__builtin_amdgcn_permlane32_swap(__float_as_uint(l_reg),__float_as_uint(l_reg),false,false);l_reg=__uint_as_float(rr[0])+__uint_as_float(rr[1]);}
  if(hi==0)wsf[32+r32]=l_reg;asm volatile("s_waitcnt lgkmcnt(0)":::"memory");
  float rli[16];
  #pragma unroll
  for(int r=0;r<16;++r)rli[r]=__builtin_amdgcn_rcpf(wsf[32+crow(r,hi)]);
  bf16*Ow=O+(rowbase+q0+wid*QBLK)*PO+ocol;
  { bf16*stg=(bf16*)(shm+LDS_OST)+wid*2048;
    #pragma unroll
    for(int r=0;r<16;++r){const int orow=crow(r,hi);
      #pragma unroll
      for(int d0=0;d0<2;++d0)stg[orow*64+d0*32+r32]=__float2bfloat16(o[d0][r]*rli[r]);}
    asm volatile("s_waitcnt lgkmcnt(0)":::"memory");
    #pragma unroll
    for(int i=0;i<4;++i){const int row=i*8+(lane>>3),ch=lane&7; const u32x4 v=*(const u32x4*)(stg+row*64+ch*8); ATTN_STORE16(Ow+(long)row*PO+ch*8,v);} }
  asm volatile("s_waitcnt lgkmcnt(0)\n\ts_barrier":::"memory");
  #undef DMA_K
  #undef DMA_V
  #undef CMASK
  #undef START
  #undef RESC
  #undef ROT
}
constexpr int ATTN_LDS_BYTES=LDS_BYTES;
struct AttnTensors { const bf16* Q; const bf16* K; const bf16* V; bf16* O; };
struct AttnUnit { int bh; int qb; };
struct StaticOrder {
  int vcu, G;
  __device__ __forceinline__ explicit StaticOrder(int grid,int block):vcu((grid%8==0)?(block%8)*(grid/8)+block/8:block),G(grid){}
  __device__ __forceinline__ bool next(int i,AttnUnit&u)const{
    if(G==256){ if(i>=8)return false; const int s=vcu&1; u.bh=vcu>>1; u.qb=2*i+((i&1)^s); return true; }
    const int L=i*G+vcu; if(L>=BATCH*NHEAD*NQB)return false; u.bh=L/NQB; u.qb=NQB-1-(L%NQB); return true; }
  __device__ __forceinline__ void a_ready(const AttnUnit&)const{}
  __device__ __forceinline__ void done(const AttnUnit&)const{}
};
template<class Sched,int THRL=8> __device__ __forceinline__ void attn_phase(char*lds,const AttnTensors&T,const Sched&S){
  AttnUnit u;
  for(int i=0;S.next(i,u);++i){ S.a_ready(u); attn_unit<THRL>(u.bh/NHEAD,u.bh%NHEAD,u.qb,T.Q,T.K,T.V,T.O,lds); S.done(u); }
}
#undef SBAR
#undef WAIT_BAR
}
namespace cg = cooperative_groups;
#ifndef REP_P0
#define REP_P0 1
#endif
#ifndef REP_P1
#define REP_P1 1
#endif
#ifndef REP_P2
#define REP_P2 1
#endif
#ifndef REP_P2b
#define REP_P2b 1
#endif
#ifndef REP_P2c
#define REP_P2c 1
#endif
#ifndef REP_P3
#define REP_P3 1
#endif
#ifndef REP_P3b
#define REP_P3b 1
#endif
#ifndef REP_P4
#define REP_P4 1
#endif
#ifndef REP_P6
#define REP_P6 1
#endif
#ifndef EXTRA_SYNCS
#define EXTRA_SYNCS 0
#endif

#ifndef PG_ALIGN
#define PG_ALIGN true
#endif
#ifndef PG_SP2
#define PG_SP2 true
#endif
constexpr int NWAVES = 8;
constexpr int BATCH = 4, SEQ = 4096, DMODEL = 1024, DIN = 2048, INCOLS = 6144, M = BATCH * SEQ;
constexpr size_t MiB = 1u << 20;
constexpr size_t WS_BAR = 16384;
constexpr size_t WS_WIN = 1 * MiB;
constexpr size_t WS_WOUT = 13 * MiB;
constexpr size_t WS_POOLW = 17 * MiB;
constexpr size_t WS_ROPE = 17 * MiB + 512 * 1024;
constexpr size_t WS_A = 19 * MiB;
constexpr size_t WS_Q = 51 * MiB, WS_K = 83 * MiB, WS_V = 115 * MiB;
constexpr size_t WS_Y = 51 * MiB;
constexpr size_t WS_XN = 147 * MiB;
constexpr size_t WS_O = 179 * MiB;
constexpr size_t WS_OUT0 = 179 * MiB;
constexpr size_t WS_STATS = 51 * MiB;
constexpr size_t WS_U = 56 * MiB, WS_V1 = 120 * MiB, WS_G1 = 184 * MiB;
constexpr size_t WS_OUT1 = 120 * MiB;
constexpr size_t WS_WOUT1 = 248 * MiB;
constexpr size_t WS_SGUW = 252 * MiB;
constexpr size_t WS_END = 253 * MiB;
constexpr int LDS_BYTES = 147456;
#define GAS __attribute__((address_space(1)))
#define LAS __attribute__((address_space(3)))
typedef unsigned short bf16;
typedef unsigned v4u __attribute__((ext_vector_type(4)));
typedef unsigned v2u __attribute__((ext_vector_type(2)));
typedef float f32x4 __attribute__((ext_vector_type(4)));
typedef short bf16x8 __attribute__((ext_vector_type(8)));
#define LDS_WAIT() asm volatile("s_waitcnt lgkmcnt(0)" ::: "memory")
__device__ __forceinline__ unsigned f2bf(float f) { unsigned u = __builtin_bit_cast(unsigned, f); return (u + 0x7fffu + ((u >> 16) & 1u)) >> 16; }
__device__ __forceinline__ unsigned pk2(float lo, float hi) { return pg8::cvt_pk_bf16(lo, hi); }
__device__ __forceinline__ float bflo(unsigned w) { return __uint_as_float(w << 16); }
__device__ __forceinline__ float bfhi(unsigned w) { return __uint_as_float(w & 0xffff0000u); }
__device__ __forceinline__ float wave_sum(float v) {
    v += pg8::swz_xor<1>(v); v += pg8::swz_xor<2>(v); v += pg8::swz_xor<4>(v); v += pg8::swz_xor<8>(v); v += pg8::swz_xor<16>(v);
    return pg8::half_sum(v);
}
#define XB_TMO      128
#define XB_XCNT(j)  (256  + 64 * (j))
#define XB_XSUB(j)  (1280 + 64 * (j))
#define XB_XGEN(j)  (2304 + 64 * (j))
#define XB_TOP      3328
#define XB_TOPGEN   3392
#define XCD_BAR_WORDS 3456
#define XB_SPIN_CAP (1u << 18)

__device__ __forceinline__ unsigned xb_ld(unsigned* p)              { return __hip_atomic_load(p, __ATOMIC_RELAXED, __HIP_MEMORY_SCOPE_AGENT); }
__device__ __forceinline__ unsigned xb_add(unsigned* p, unsigned v) { return __hip_atomic_fetch_add(p, v, __ATOMIC_RELAXED, __HIP_MEMORY_SCOPE_AGENT); }
__device__ __forceinline__ unsigned xb_xcc_id() { return (unsigned)__builtin_amdgcn_s_getreg((3 << 11) | 20) & 0xFu; }
#define XB_SPIN(cond, bar) do { unsigned _sp = 0; while (cond) { __builtin_amdgcn_s_sleep(1); \
    if ((++_sp & 255u) == 0u) { if (xb_ld(&(bar)[XB_TMO])) break; if (_sp > XB_SPIN_CAP) { atomicAdd(&(bar)[XB_TMO], 1u); break; } } } } while (0)

struct XcdBarrier {
    unsigned* bar; unsigned x;
    volatile LAS unsigned* st;
};

__device__ __forceinline__ XcdBarrier xcd_barrier_post(unsigned* bar, volatile LAS unsigned* st) {
    XcdBarrier b; b.bar = bar; b.x = xb_xcc_id(); b.st = st;
    if (threadIdx.x == 0) (void)xb_add(&bar[XB_XCNT(b.x)], 1u);
    return b;
}
__device__ __forceinline__ void xcd_barrier_complete(unsigned* bar, unsigned x, unsigned& nloc, unsigned& nx) {
    const unsigned G = gridDim.x * gridDim.y * gridDim.z;
    unsigned sum, cnt, mine, sp = 0u;
    for (;;) {
        sum = 0u; cnt = 0u; mine = 0u;
#pragma unroll
        for (unsigned j = 0; j < 16; ++j) { const unsigned c = xb_ld(&bar[XB_XCNT(j)]); sum += c; cnt += (c > 0u) ? 1u : 0u; mine = (j == x) ? c : mine; }
        if (sum == G) break;
        __builtin_amdgcn_s_sleep(1);
        if ((++sp & 255u) == 0u) { if (xb_ld(&bar[XB_TMO])) break; if (sp > XB_SPIN_CAP) { atomicAdd(&bar[XB_TMO], 1u); break; } }
    }
    nloc = mine > 0u ? mine : 1u; nx = cnt > 0u ? cnt : 1u;
}

__device__ __forceinline__ void xcd_barrier(const XcdBarrier& b) {
    asm volatile("s_waitcnt vmcnt(0)" ::: "memory");
    __syncthreads();
    if (threadIdx.x == 0) {
        unsigned* bar = b.bar;
        __builtin_amdgcn_s_waitcnt(0);
        unsigned nloc = b.st[0], nx = b.st[1];
        if (nloc == 0u) { xcd_barrier_complete(bar, b.x, nloc, nx); b.st[0] = nloc; b.st[1] = nx; }
        const unsigned old = xb_add(&bar[XB_XSUB(b.x)], 1u);
        const unsigned gen = old / nloc;
        if (old + 1u == (gen + 1u) * nloc) {
            __builtin_amdgcn_fence(__ATOMIC_RELEASE, "agent");
            asm volatile("s_waitcnt vmcnt(0)" ::: "memory");
            const unsigned og = xb_add(&bar[XB_TOP], 1u);
            const unsigned tg = og / nx;
            if (og + 1u == (tg + 1u) * nx) xb_add(&bar[XB_TOPGEN], 1u);
            else XB_SPIN(xb_ld(&bar[XB_TOPGEN]) == tg, bar);
            __builtin_amdgcn_fence(__ATOMIC_ACQUIRE, "agent");
            xb_add(&bar[XB_XGEN(b.x)], 1u);
            asm volatile("s_waitcnt vmcnt(0)" ::: "memory");
        } else {
            XB_SPIN(xb_ld(&bar[XB_XGEN(b.x)]) == gen, bar);
            __builtin_amdgcn_fence(__ATOMIC_ACQUIRE, "agent");
            asm volatile("s_waitcnt vmcnt(0)" ::: "memory");
        }
    }
    __syncthreads();
}
struct Frame { LAS unsigned char* lds; int tid, lane, wave, vcu, G; };
__device__ __forceinline__ unsigned long long ldp(LAS unsigned long long* PT, int k) { asm volatile("" ::: "memory"); const unsigned long long v = PT[k]; const unsigned lo = __builtin_amdgcn_readfirstlane((unsigned)v), hi = __builtin_amdgcn_readfirstlane((unsigned)(v >> 32)); return ((unsigned long long)hi << 32) | lo; }

__device__ __forceinline__ void p0_transpose_item(const float* W, int K, int N, bf16* WT, int row_off, LAS float* scr, int item, int lane) {
    const int nblk = N / 32, kb = item / nblk, nb = item % nblk, k0 = 64 * kb, n0 = 32 * nb;
#pragma unroll 8
    for (int i = 0; i < 32; ++i) { const int kk = 2 * i + (lane >> 5); scr[kk * 33 + (lane & 31)] = W[(size_t)(k0 + kk) * N + n0 + (lane & 31)]; }
    LDS_WAIT(); asm volatile("" ::: "memory");
    const int c = lane & 7;
#pragma unroll
    for (int j = 0; j < 4; ++j) { const int n = (lane >> 3) + 8 * j; const LAS float* s = scr + (8 * c) * 33 + n;
        v4u o; o.x = pk2(s[0 * 33], s[1 * 33]); o.y = pk2(s[2 * 33], s[3 * 33]); o.z = pk2(s[4 * 33], s[5 * 33]); o.w = pk2(s[6 * 33], s[7 * 33]);
        *(v4u*)(WT + (size_t)(row_off + n0 + n) * K + k0 + 8 * c) = o; }
    LDS_WAIT(); asm volatile("" ::: "memory");
}
__device__ __forceinline__ void rms_row_to_bf16(const float* xrow, const float* gain, bf16* orow, int lane) {
    const f32x4* xr = (const f32x4*)xrow + lane; const f32x4* gr = (const f32x4*)gain + lane;
    f32x4 v[4]; float s = 0.f;
#pragma unroll
    for (int j = 0; j < 4; ++j) { v[j] = xr[64 * j]; s += (v[j].x * v[j].x + v[j].y * v[j].y) + (v[j].z * v[j].z + v[j].w * v[j].w); }
    const float rstd = 1.f / sqrtf(wave_sum(s) * (1.f / DMODEL) + 1e-6f);
    v2u* o8 = (v2u*)orow + lane;
#pragma unroll
    for (int j = 0; j < 4; ++j) { const f32x4 g = gr[64 * j]; v2u w; w.x = pk2(v[j].x * rstd * g.x, v[j].y * rstd * g.y); w.y = pk2(v[j].z * rstd * g.z, v[j].w * rstd * g.w); o8[64 * j] = w; }
}
template <bool NEXT> __device__ __forceinline__ void post_row(const float* orow, const float* xin, const float* gpost, float* xout, const float* gpre, bf16* xn, int lane) {
    const f32x4* pr = (const f32x4*)orow + lane; const f32x4* xr = (const f32x4*)xin + lane; const f32x4* gr = (const f32x4*)gpost + lane;
    f32x4 v[4]; float s = 0.f;
#pragma unroll
    for (int j = 0; j < 4; ++j) { v[j] = pr[64 * j]; s += (v[j].x * v[j].x + v[j].y * v[j].y) + (v[j].z * v[j].z + v[j].w * v[j].w); }
    const float rstd = 1.f / sqrtf(wave_sum(s) * (1.f / DMODEL) + 1e-6f); float s2 = 0.f;
#pragma unroll
    for (int j = 0; j < 4; ++j) { v[j] = xr[64 * j] + v[j] * rstd * gr[64 * j]; ((f32x4*)xout + lane)[64 * j] = v[j]; s2 += (v[j].x * v[j].x + v[j].y * v[j].y) + (v[j].z * v[j].z + v[j].w * v[j].w); }
    if (NEXT) { const float r2 = 1.f / sqrtf(wave_sum(s2) * (1.f / DMODEL) + 1e-6f); const f32x4* g2 = (const f32x4*)gpre + lane; v2u* o8 = (v2u*)xn + lane;
#pragma unroll
        for (int j = 0; j < 4; ++j) { const f32x4 g = g2[64 * j]; v2u w; w.x = pk2(v[j].x * r2 * g.x, v[j].y * r2 * g.y); w.y = pk2(v[j].z * r2 * g.z, v[j].w * r2 * g.w); o8[64 * j] = w; } }
}
__device__ __forceinline__ void combine_row(const bf16* O, const bf16* G, const float* subln, bf16* Y, int row, float lam, int lane) {
    const int h = lane >> 3, j = lane & 7;
    const v4u* p0 = (const v4u*)(O + (size_t)row * 2048 + h * 256 + j * 16); const v4u* p1 = (const v4u*)(O + (size_t)row * 2048 + h * 256 + 128 + j * 16);
    const v4u a0 = p0[0], a1 = p0[1], b0 = p1[0], b1 = p1[1];
    float d[16];
#pragma unroll
    for (int k = 0; k < 4; ++k) { d[2 * k] = bflo(a0[k]) - lam * bflo(b0[k]); d[2 * k + 1] = bfhi(a0[k]) - lam * bfhi(b0[k]); d[8 + 2 * k] = bflo(a1[k]) - lam * bflo(b1[k]); d[8 + 2 * k + 1] = bfhi(a1[k]) - lam * bfhi(b1[k]); }
    float ss = 0.f;
#pragma unroll
    for (int k = 0; k < 16; ++k) ss += d[k] * d[k];
    ss += pg8::swz_xor<1>(ss); ss += pg8::swz_xor<2>(ss); ss += pg8::swz_xor<4>(ss);
    const float rstd = 0.8f / sqrtf(ss * (1.f / 128.f) + 1e-5f);
    const v4u* gp = (const v4u*)(G + (size_t)row * 2048 + 1024 + h * 128 + j * 16); const v4u g0 = gp[0], g1 = gp[1];
    const f32x4* sp = (const f32x4*)(subln + j * 16); const f32x4 s0 = sp[0], s1 = sp[1], s2 = sp[2], s3 = sp[3];
    const float sl[16] = {s0.x, s0.y, s0.z, s0.w, s1.x, s1.y, s1.z, s1.w, s2.x, s2.y, s2.z, s2.w, s3.x, s3.y, s3.z, s3.w};
    v4u o0, o1;
#pragma unroll
    for (int k = 0; k < 4; ++k) { o0[k] = pk2(d[2 * k] * rstd * sl[2 * k] * bflo(g0[k]), d[2 * k + 1] * rstd * sl[2 * k + 1] * bfhi(g0[k]));
        o1[k] = pk2(d[8 + 2 * k] * rstd * sl[8 + 2 * k] * bflo(g1[k]), d[8 + 2 * k + 1] * rstd * sl[8 + 2 * k + 1] * bfhi(g1[k])); }
    v4u* yp = (v4u*)(Y + (size_t)row * 2048 + 1024 + h * 128 + j * 16); yp[0] = o0; yp[1] = o1;
}
#ifdef PROBE_NOSKIP
#define SGU_TB0(ks) 0
#else
#define SGU_TB0(ks) (2 * (ks))
#endif
#ifndef ATT_THRL
#define ATT_THRL 8
#endif
constexpr int SG_W = 0, SG_VT = 34816, SG_ST = 34816 + 69632, SG_STRIDE = 272, SG_MSTRIDE = 528;
__device__ __forceinline__ void sgu_unit(const Frame& F, int ch, int g, bf16* U, const bf16* V, const bf16* G, const float* stats, const bf16* Wm, const float* lng, const float* lnb, const float* sgub, bool dry = false) {
    LAS unsigned char* lds = F.lds; const int tid = F.tid, lane = F.lane, wave = F.wave; const int row0 = ch * 128;
    LAS float* ST = (LAS float*)(lds + SG_ST);
    if (tid < 128) { const f32x4* p = (const f32x4*)(stats + (size_t)(row0 + tid) * 64); float s = 0.f, q = 0.f;
#ifdef PROBE_STATS
        for (int k = 0; k < 256; ++k) { const v4u r = *(const v4u*)(V + (size_t)(row0 + tid) * 2048 + k * 8);
#pragma unroll
            for (int e = 0; e < 4; ++e) { const float lo = bflo(r[e]), hi = bfhi(r[e]); s += lo + hi; q += lo * lo + hi * hi; } }
#else
#pragma unroll
        for (int k = 0; k < 16; ++k) { const f32x4 t = p[k]; s += t.x + t.z; q += t.y + t.w; }
#endif
        const float mu = s * (1.f / 2048.f), var = q * (1.f / 2048.f) - mu * mu; ST[2 * tid] = mu; ST[2 * tid + 1] = 1.f / sqrtf(var + 1e-6f); }
#pragma unroll
    for (int i = 0; i < 4; ++i) { const int c = tid + 512 * i, t = c >> 4, k8 = c & 15; const v4u w = *(const v4u*)(Wm + (size_t)(g * 128 + t) * 128 + k8 * 8); *(LAS v4u*)(lds + SG_W + t * SG_STRIDE + k8 * 16) = w; }
    __syncthreads();
    { const int db = tid & 31, sb = tid >> 5, d0 = db * 8, s0 = sb * 8;
      const f32x4 ga = *(const f32x4*)(lng + g * 256 + d0), gb = *(const f32x4*)(lng + g * 256 + d0 + 4), ba = *(const f32x4*)(lnb + g * 256 + d0), bb = *(const f32x4*)(lnb + g * 256 + d0 + 4);
      const float gl[8] = {ga.x, ga.y, ga.z, ga.w, gb.x, gb.y, gb.z, gb.w}, bl[8] = {ba.x, ba.y, ba.z, ba.w, bb.x, bb.y, bb.z, bb.w};
      float f[8][8];
#pragma unroll
      for (int i = 0; i < 8; ++i) { const v4u raw = *(const v4u*)(V + (size_t)(row0 + s0 + i) * 2048 + g * 256 + d0); const float mu = ST[2 * (s0 + i)], rs = ST[2 * (s0 + i) + 1];
#pragma unroll
          for (int k = 0; k < 4; ++k) { f[i][2 * k] = (bflo(raw[k]) - mu) * rs * gl[2 * k] + bl[2 * k]; f[i][2 * k + 1] = (bfhi(raw[k]) - mu) * rs * gl[2 * k + 1] + bl[2 * k + 1]; } }
#pragma unroll
      for (int dd = 0; dd < 8; ++dd) { v4u w; w.x = pk2(f[0][dd], f[1][dd]); w.y = pk2(f[2][dd], f[3][dd]); w.z = pk2(f[4][dd], f[5][dd]); w.w = pk2(f[6][dd], f[7][dd]);
          *(LAS v4u*)(lds + SG_VT + (d0 + dd) * SG_STRIDE + s0 * 2) = w; } }
    __syncthreads();
    f32x4 acc[2][8];
#pragma unroll
    for (int a = 0; a < 2; ++a)
#pragma unroll
        for (int b = 0; b < 8; ++b) acc[a][b] = (f32x4){0.f, 0.f, 0.f, 0.f};
    const int fr = lane & 15, fq = lane >> 4;
#pragma unroll
    for (int ks = 0; ks < 4; ++ks) { bf16x8 af[2];
#pragma unroll
        for (int a = 0; a < 2; ++a) af[a] = *(const LAS bf16x8*)(lds + SG_VT + (32 * wave + 16 * a + fr) * SG_STRIDE + (32 * ks + 8 * fq) * 2);
#pragma unroll
        for (int tb = SGU_TB0(ks); tb < 8; ++tb) { const bf16x8 bfr = *(const LAS bf16x8*)(lds + SG_W + (16 * tb + fr) * SG_STRIDE + (32 * ks + 8 * fq) * 2);
#pragma unroll
            for (int a = 0; a < 2; ++a) acc[a][tb] = __builtin_amdgcn_mfma_f32_16x16x32_bf16(af[a], bfr, acc[a][tb], 0, 0, 0); } }
    __syncthreads();
#pragma unroll
    for (int a = 0; a < 2; ++a)
#pragma unroll
        for (int tb = 0; tb < 8; ++tb) { v2u w; w.x = pk2(acc[a][tb][0], acc[a][tb][1]); w.y = pk2(acc[a][tb][2], acc[a][tb][3]);
            *(LAS v2u*)(lds + SG_VT + (16 * tb + fr) * SG_MSTRIDE + (32 * wave + 16 * a + 4 * fq) * 2) = w; }
    __syncthreads();
#pragma unroll
    for (int i = 0; i < 8; ++i) { const int c = tid + 512 * i, t = c >> 5, d8 = c & 31; const size_t off = (size_t)(row0 + t) * 2048 + g * 256 + d8 * 8;
        const v4u uu = *(const v4u*)(U + off), gg = *(const v4u*)(G + off), mm = *(const LAS v4u*)(lds + SG_VT + t * SG_MSTRIDE + d8 * 16); const float bs = sgub[g * 128 + t];
        v4u o;
#pragma unroll
        for (int k = 0; k < 4; ++k) o[k] = pk2(bflo(uu[k]) * (bflo(mm[k]) + bs) * bflo(gg[k]), bfhi(uu[k]) * (bfhi(mm[k]) + bs) * bfhi(gg[k]));
        if (!dry || bs == 12345.678f) *(v4u*)(U + off) = o; }
    __syncthreads();
}


#ifdef CHECK
#ifndef CHK_TOL
#define CHK_TOL 0.06f
#endif
constexpr size_t WS_CHK = 250 * MiB;
__device__ __forceinline__ unsigned hsh(unsigned x) { x ^= x >> 16; x *= 0x7feb352du; x ^= x >> 15; x *= 0x846ca68bu; x ^= x >> 16; return x; }
__device__ __forceinline__ float bfv(const bf16* p) { return __uint_as_float((unsigned)(*p) << 16); }
__device__ __forceinline__ float wdot(const bf16* a, const bf16* b, int n, int lane) { float s = 0.f;
    for (int k = lane * 8; k < n; k += 512) { const v4u x = *(const v4u*)(a + k), y = *(const v4u*)(b + k);
#pragma unroll
        for (int e = 0; e < 4; ++e) s += bflo(x[e]) * bflo(y[e]) + bfhi(x[e]) * bfhi(y[e]); }
    return wave_sum(s); }
__device__ __forceinline__ float wave_max(float v) { v = fmaxf(v, pg8::swz_xor<1>(v)); v = fmaxf(v, pg8::swz_xor<2>(v)); v = fmaxf(v, pg8::swz_xor<4>(v)); v = fmaxf(v, pg8::swz_xor<8>(v)); v = fmaxf(v, pg8::swz_xor<16>(v));
    auto rr = __builtin_amdgcn_permlane32_swap(__float_as_uint(v), __float_as_uint(v), false, false); return fmaxf(__uint_as_float(rr[0]), __uint_as_float(rr[1])); }
__device__ __forceinline__ void chk_put(unsigned* chk, int k, float got, float want, float tol_abs) { float e = fabsf(got - want) / (fabsf(want) + tol_abs); if (!(e == e)) e = 1e9f; e = wave_max(e); atomicMax(chk + k, __float_as_uint(e)); }
#define CHKPTR ((unsigned*)(GAS unsigned*)(ldp(PT, 18) + WS_CHK))
#endif
struct Args { const float* in[17]; const int* pos; float* out; unsigned char* ws; };
__global__ void __launch_bounds__(NWAVES * 64, 2) fwd_megakernel(Args args) {
    extern __shared__ __attribute__((aligned(16))) unsigned char lds[];
    cg::grid_group grid = cg::this_grid();
    Frame F; F.lds = (LAS unsigned char*)lds; F.tid = threadIdx.x; F.lane = F.tid & 63; F.wave = __builtin_amdgcn_readfirstlane(F.tid >> 6);
    F.G = gridDim.x; { const int bx = blockIdx.x; F.vcu = (F.G % 8 == 0) ? (bx % 8) * (F.G / 8) + bx / 8 : bx; }
    LAS unsigned long long* PT = (LAS unsigned long long*)(F.lds + 131072 + 1024);
    if (F.tid < 4) ((LAS unsigned*)(F.lds + 131072 + 512))[F.tid] = 0u;
    if (F.tid == 0) {
#define PTSET(k) PT[k] = (unsigned long long)args.in[k]
        PTSET(0); PTSET(1); PTSET(2); PTSET(3); PTSET(4); PTSET(5); PTSET(6); PTSET(7); PTSET(8); PTSET(9); PTSET(10); PTSET(11); PTSET(12); PTSET(13); PTSET(14); PTSET(15); PTSET(16);
#undef PTSET
        PT[17] = (unsigned long long)args.out; PT[18] = (unsigned long long)args.ws; }
    __syncthreads();
    int n_stamp = 0; (void)n_stamp;
    { XcdBarrier xb0 = xcd_barrier_post((unsigned*)(GAS unsigned*)(ldp(PT, 18) + WS_BAR), (volatile LAS unsigned*)(F.lds + 131072 + 512));
      if (F.tid == 0) ((volatile LAS unsigned*)(F.lds + 131072 + 512))[2] = xb0.x; }
#define GRID_SYNC_CG() do { asm volatile("s_waitcnt vmcnt(0) lgkmcnt(0)" ::: "memory"); grid.sync(); if (F.wave == 0) asm volatile("buffer_inv sc1\n\ts_waitcnt vmcnt(0)" ::: "memory"); __syncthreads(); STAMP(); } while (0)
#ifdef ALL_CG_SYNC
#define GRID_SYNC() GRID_SYNC_CG()
#else
#define GRID_SYNC() do { XcdBarrier xb_; xb_.st = (volatile LAS unsigned*)(F.lds + 131072 + 512); xb_.bar = (unsigned*)(GAS unsigned*)(ldp(PT, 18) + WS_BAR); xb_.x = (threadIdx.x == 0) ? xb_.st[2] : 0u; xcd_barrier(xb_); STAMP(); } while (0)
#endif
#ifdef TIMING
#define STAMP() do { if (blockIdx.x == 0 && threadIdx.x == 0) { ((unsigned long long*)((GAS unsigned char*)ldp(PT, 18) + 252 * MiB))[n_stamp] = __builtin_amdgcn_s_memrealtime(); } ++n_stamp; } while (0)
#else
#define STAMP() do { } while (0)
#endif
#define REFRESH() do { int t_ = threadIdx.x; asm volatile("" : "+v"(t_)); F.tid = t_; F.lane = t_ & 63; } while (0)
#define PIN(k) ((const float*)(const GAS float*)ldp(PT, k))
#define POUT ((float*)(GAS float*)ldp(PT, 17))
#define WSB(off) ((bf16*)(GAS bf16*)(ldp(PT, 18) + (off)))
#define WSF(off) ((float*)(GAS float*)(ldp(PT, 18) + (off)))
    const int gw = F.vcu * NWAVES + F.wave, NGW = F.G * NWAVES;
    LAS float* scr = (LAS float*)(F.lds + F.wave * 16384);

    if (F.G == 0x7fffffff) grid.sync();
#ifndef REPN_P0
#define REPN_P0 1
#endif
    for (int rr_ = 0; rr_ < REPN_P0; ++rr_) {
    {
        REFRESH();
        const float *x = PIN(0), *pre_norm = PIN(2), *w_in = PIN(4), *w_out = PIN(5), *pool_w = PIN(6), *sgu_w = PIN(15); const int* pos = (const int*)PIN(1);
        bf16 *Win_t = WSB(WS_WIN), *Wout_t = WSB(WS_WOUT), *Wout1_t = WSB(WS_WOUT1), *Poolw_t = WSB(WS_POOLW), *Sguw = WSB(WS_SGUW), *XN = WSB(WS_XN); float* rope = WSF(WS_ROPE);
        constexpr int I_IN = (DMODEL / 64) * (INCOLS / 32), I_OUT = (DIN / 64) * (DMODEL / 32), I_PW = (256 / 64) * (256 / 32);
        for (int it = gw; it < I_IN + 2 * I_OUT + 4 * I_PW; it += NGW) { int r = it;
            if (r < I_IN) { p0_transpose_item(w_in, DMODEL, INCOLS, Win_t, 0, scr, r, F.lane); continue; } r -= I_IN;
            if (r < I_OUT) { p0_transpose_item(w_out, DIN, DMODEL, Wout_t, 0, scr, r, F.lane); continue; } r -= I_OUT;
            if (r < I_OUT) { p0_transpose_item(w_out + (size_t)DIN * DMODEL, DIN, DMODEL, Wout1_t, 0, scr, r, F.lane); continue; } r -= I_OUT;
            const int gq = r / I_PW; p0_transpose_item(pool_w + (size_t)gq * 65536, 256, 256, Poolw_t, gq * 256, scr, r % I_PW, F.lane); }
        for (int i = blockIdx.x * 512 + F.tid; i < M * 8; i += F.G * 512) { const int row = i >> 3, k = i & 7;
            const float inv = __powf(500000.0f, -(float)k * 0.125f); const float ang = (float)pos[row] * inv; float sn, cs; sincosf(ang, &sn, &cs);
            rope[(size_t)row * 16 + k] = cs; rope[(size_t)row * 16 + 8 + k] = sn; }
        for (int i = blockIdx.x * 512 + F.tid; i < 8 * 128 * 128; i += F.G * 512) { const int s = i & 127, t = (i >> 7) & 127; Sguw[i] = (bf16)((s <= t) ? f2bf(sgu_w[i]) : 0u); }
        for (int m = gw; m < M; m += NGW) rms_row_to_bf16(x + (size_t)m * DMODEL, pre_norm, XN + (size_t)m * DMODEL, F.lane);
    }
    if (rr_ + 1 < REPN_P0) GRID_SYNC();
    }
    GRID_SYNC();
#ifndef REPN_P1
#define REPN_P1 1
#endif
    for (int rr_ = 0; rr_ < REPN_P1; ++rr_) {
    {
        bf16 *XN = WSB(WS_XN), *Win_t = WSB(WS_WIN), *Abuf = WSB(WS_A), *G0 = (bf16*)POUT; float* rope = WSF(WS_ROPE);
        pg8::Gemm g{XN, Win_t, M, INCOLS, DMODEL, DMODEL, DMODEL, 0}; pg8::StaticOrder S; S.init(M, INCOLS, F.G, (int)blockIdx.x);
        pg8::EpiProj0 E{Abuf, G0, (size_t)(WS_Q - WS_A) / 2, rope, attn_body::C2};
        pg8::gemm_phase<pg8::EpiProj0, pg8::StaticOrder, true, true>(F.lds, g, S, E);
    }
    if (rr_ + 1 < REPN_P1) GRID_SYNC();
    }
    GRID_SYNC();
#ifndef REPN_P2
#define REPN_P2 1
#endif
    for (int rr_ = 0; rr_ < REPN_P2; ++rr_) {
    {
        REFRESH();
        { const float* w_in = PIN(4); bf16* Win_t = WSB(WS_WIN); constexpr int I_IN = (DMODEL / 64) * (INCOLS / 32);
          for (int it = gw; it < I_IN; it += NGW) p0_transpose_item(w_in + (size_t)DMODEL * INCOLS, DMODEL, INCOLS, Win_t, 0, scr, it, F.lane); }
        { bf16 *Abuf = WSB(WS_A), *XN = WSB(WS_XN);
          for (int task = blockIdx.x * 512 + F.tid; task < (M / 16) * 128; task += F.G * 512) { const int rb = task >> 7, ck = task & 127, r0 = rb * 16, s0 = r0 & (SEQ - 1), w = 2 << (ck >> 5);
            const bf16* ap = Abuf + (size_t)r0 * 1024 + ck * 8; bf16* op = XN + (size_t)r0 * 1024 + ck * 8;
            float sum[8];
#pragma unroll
            for (int k = 0; k < 8; ++k) sum[k] = 0.f;
            if (s0 != 0) for (int j = 1; j < w; ++j) { const v4u r = *(const v4u*)(ap - (size_t)j * 1024);
#pragma unroll
                for (int k = 0; k < 4; ++k) { sum[2 * k] += bflo(r[k]); sum[2 * k + 1] += bfhi(r[k]); } }
#pragma unroll
            for (int i = 0; i < 16; ++i) { const v4u c = *(const v4u*)(ap + (size_t)i * 1024); const bool sub = (s0 != 0) ? (i >= 1) : (i >= w);
                v4u od = (v4u){0u, 0u, 0u, 0u}; if (sub) od = *(const v4u*)(ap + (ptrdiff_t)(i - w) * 1024);
                const int s = s0 + i, cnt = (s + 1 < w) ? s + 1 : w; const float rc = 1.f / (float)cnt; v4u o;
#pragma unroll
                for (int k = 0; k < 4; ++k) { const float lo = bflo(c[k]), hi = bfhi(c[k]); sum[2 * k] += lo - bflo(od[k]); sum[2 * k + 1] += hi - bfhi(od[k]); o[k] = pk2(sum[2 * k] * rc - lo, sum[2 * k + 1] * rc - hi); }
                *(v4u*)(op + (size_t)i * 1024) = o; } } }
        asm volatile("s_waitcnt vmcnt(0) lgkmcnt(0)" ::: "memory"); __syncthreads();
        bf16 *Qb = WSB(WS_Q), *Kb = WSB(WS_K), *Vb = WSB(WS_V), *Ob = WSB(WS_O);
        const attn_body::AttnTensors AT{(const attn_body::bf16*)Qb, (const attn_body::bf16*)Kb, (const attn_body::bf16*)Vb, (attn_body::bf16*)Ob};
        const attn_body::StaticOrder S((int)F.G, (int)blockIdx.x);
        attn_body::attn_phase<attn_body::StaticOrder, 8>((char*)lds, AT, S);
    }
    if (rr_ + 1 < REPN_P2) GRID_SYNC();
    }
    GRID_SYNC();
#ifndef REPN_P2b
#define REPN_P2b 1
#endif
    for (int rr_ = 0; rr_ < REPN_P2b; ++rr_) {
    {
        { const float* pool_scale = PIN(7); bf16 *XN = WSB(WS_XN), *Poolw_t = WSB(WS_POOLW), *Yb = WSB(WS_Y), *G0 = (bf16*)POUT;
          pg8::Gemm g{XN, Poolw_t, M, 1024, 256, 1024, 256, 512}; pg8::StaticOrder S; S.init(M, 1024, F.G, (int)blockIdx.x);
          pg8::EpiPool E{Yb, G0, pool_scale};
#ifndef RX_POOLG
#define RX_POOLG 1
#endif
          for (int rx_ = 0; rx_ < RX_POOLG; ++rx_)
          pg8::gemm_phase<pg8::EpiPool, pg8::StaticOrder, true, true>(F.lds, g, S, E); }
        REFRESH();
        const float *lq1 = PIN(8), *lk1 = PIN(9), *lq2 = PIN(10), *lk2 = PIN(11), *subln = PIN(12); bf16 *Ob = WSB(WS_O), *Yb = WSB(WS_Y), *G0 = (bf16*)POUT;
        float lam; { const float a = wave_sum(lq1[F.lane] * lk1[F.lane]), b = wave_sum(lq2[F.lane] * lk2[F.lane]); lam = expf(a) - expf(b) + 0.2f; }
#ifndef RX_COMBINE
#define RX_COMBINE 1
#endif
        for (int rx_ = 0; rx_ < RX_COMBINE; ++rx_)
        for (int m = gw; m < M; m += NGW) combine_row(Ob, G0, subln, Yb, m, lam, F.lane);
    }
    if (rr_ + 1 < REPN_P2b) GRID_SYNC();
    }
    GRID_SYNC();
#ifdef PROBE_P3
    for (int r_ = 0; r_ < PROBE_P3; ++r_)
#endif
    {
        bf16 *Yb = WSB(WS_Y), *Wout_t = WSB(WS_WOUT); float* out0 = WSF(WS_OUT0);
        pg8::Gemm g{Yb, Wout_t, M, DMODEL, DIN, DIN, DIN, 0}; pg8::StaticOrder S; S.init(M, DMODEL, F.G, (int)blockIdx.x);
        pg8::EpiF32 E{out0, DMODEL};
        pg8::gemm_phase<pg8::EpiF32, pg8::StaticOrder, true, true>(F.lds, g, S, E);
#ifdef PROBE_P3
        GRID_SYNC();
#endif
    }
    GRID_SYNC();
    {
        REFRESH();
        const float *x = PIN(0), *pre_norm = PIN(2), *post_norm = PIN(3); float *out = POUT, *out0 = WSF(WS_OUT0); bf16* Abuf = WSB(WS_A);
        for (int m = gw; m < M; m += NGW) post_row<true>(out0 + (size_t)m * DMODEL, x + (size_t)m * DMODEL, post_norm, out + (size_t)m * DMODEL, pre_norm + DMODEL, Abuf + (size_t)m * DMODEL, F.lane);
    }
    GRID_SYNC();
#ifndef REPN_P4
#define REPN_P4 1
#endif
    for (int rr_ = 0; rr_ < REPN_P4; ++rr_) {
    {
        bf16 *Abuf = WSB(WS_A), *Win_t = WSB(WS_WIN), *Ub = WSB(WS_U); float* stats = WSF(WS_STATS);
        pg8::Gemm g{Abuf, Win_t, M, INCOLS, DMODEL, DMODEL, DMODEL, 0}; pg8::StaticOrder S; S.init(M, INCOLS, F.G, (int)blockIdx.x);
        pg8::EpiProj1 E{Ub, (size_t)(WS_V1 - WS_U) / 2, stats};
        pg8::gemm_phase<pg8::EpiProj1, pg8::StaticOrder, true, true>(F.lds, g, S, E);
    }
    if (rr_ + 1 < REPN_P4) GRID_SYNC();
    }
    GRID_SYNC();
    { REFRESH(); const float *ln_g = PIN(13), *ln_b = PIN(14), *sgu_b = PIN(16); bf16 *Ub = WSB(WS_U), *V1b = WSB(WS_V1), *G1b = WSB(WS_G1), *Sguw = WSB(WS_SGUW); float* stats = WSF(WS_STATS);
#ifdef PROBE_SGU_DRY
      for (int un = F.vcu; un < 128 * 8; un += F.G) sgu_unit(F, un >> 3, un & 7, Ub, V1b, G1b, stats, Sguw, ln_g, ln_b, sgu_b, true);
      GRID_SYNC(); REFRESH();
#endif
#ifdef PROBE_SYNCS
      for (int r_ = 0; r_ < PROBE_SYNCS; ++r_) GRID_SYNC();
#endif
      for (int un = F.vcu; un < 128 * 8; un += F.G) sgu_unit(F, un >> 3, un & 7, Ub, V1b, G1b, stats, Sguw, ln_g, ln_b, sgu_b); }
    GRID_SYNC();
    {
        bf16 *Ub = WSB(WS_U), *Wout1_t = WSB(WS_WOUT1); float* out1 = WSF(WS_OUT1);
        pg8::Gemm g{Ub, Wout1_t, M, DMODEL, DIN, DIN, DIN, 0}; pg8::StaticOrder S; S.init(M, DMODEL, F.G, (int)blockIdx.x);
        pg8::EpiF32 E{out1, DMODEL};
        pg8::gemm_phase<pg8::EpiF32, pg8::StaticOrder, true, true>(F.lds, g, S, E);
    }
    GRID_SYNC();
#ifdef PROBE_P3B
    for (int r_ = 0; r_ < PROBE_P3B; ++r_) { REFRESH();
        const float *x = PIN(0), *pre_norm = PIN(2), *post_norm = PIN(3); float *out0 = WSF(WS_OUT0); bf16* Abuf = WSB(WS_A); float* dummy = WSF(WS_U);
        for (int m = gw; m < M; m += NGW) post_row<true>(out0 + (size_t)m * DMODEL, x + (size_t)m * DMODEL, post_norm, dummy + (size_t)m * DMODEL, pre_norm + DMODEL, Abuf + (size_t)m * DMODEL, F.lane);
        GRID_SYNC(); }
#endif
    { REFRESH(); const float* post_norm = PIN(3); float *out = POUT, *out1 = WSF(WS_OUT1);
      for (int m = gw; m < M; m += NGW) post_row<false>(out1 + (size_t)m * DMODEL, out + (size_t)m * DMODEL, post_norm + DMODEL, out + (size_t)m * DMODEL, nullptr, nullptr, F.lane); }
}

extern "C" void kernel_launch(void* const* d_in, const int* in_sizes, int n_in, void* d_out, int out_size, void* d_ws, size_t ws_size, hipStream_t stream) {
    static int grid = 0;
    if (grid == 0) {
        if (n_in != 17 || in_sizes[0] != M * DMODEL || out_size != M * DMODEL || ws_size < WS_END) { fprintf(stderr, "kernel_launch: unexpected shapes (n_in %d, ws %zu)\n", n_in, ws_size); grid = -1; return; }
        int dev = 0, cus = 0, per_cu = 0;
        hipGetDevice(&dev); hipDeviceGetAttribute(&cus, hipDeviceAttributeMultiprocessorCount, dev);
        if (hipFuncSetAttribute((const void*)fwd_megakernel, hipFuncAttributeMaxDynamicSharedMemorySize, LDS_BYTES) != hipSuccess) { fprintf(stderr, "kernel_launch: hipFuncSetAttribute failed\n"); grid = -1; return; }
        if (hipOccupancyMaxActiveBlocksPerMultiprocessor(&per_cu, (const void*)fwd_megakernel, NWAVES * 64, LDS_BYTES) != hipSuccess || per_cu < 1) { fprintf(stderr, "kernel_launch: occupancy query says %d\n", per_cu); per_cu = 1; }
        (void)hipGetLastError();
        grid = cus * 1;
    }
    if (grid < 0) return;
    if (hipMemsetAsync(d_ws, 0, 65536, stream) != hipSuccess) { fprintf(stderr, "kernel_launch: memset of the barrier words failed\n"); return; }
    Args a{};
    for (int i = 0; i < 17; ++i) a.in[i] = (const float*)d_in[i];
    a.pos = (const int*)d_in[1]; a.out = (float*)d_out; a.ws = (unsigned char*)d_ws;
    void* kargs[] = {&a};
    hipError_t e = hipLaunchCooperativeKernel((const void*)fwd_megakernel, dim3(grid), dim3(NWAVES * 64), kargs, LDS_BYTES, stream);
    if (e != hipSuccess) fprintf(stderr, "cooperative launch failed: %s (grid %d)\n", hipGetErrorString(e), grid);
}
```
